# Optimizing an MI355X kernel written in HIP

```python
import jax, jax.numpy as jnp
from jax import lax
import numpy as np

D_MODEL = 1024
BATCH = 2
SEQ = 8192
DEPTH = 1

MIX_W = D_MODEL
POOL_W = MIX_W // 2
POOL_GROUPS = 4
POOL_GC = POOL_W // POOL_GROUPS
POOL_WINDOWS = (2, 4, 8, 16)
RWKV_C = MIX_W - POOL_W
HEAD_N = 64
N_HEAD = RWKV_C // HEAD_N
DECAY_LORA = 64
ICLR_LORA = 64
GATE_LORA = 128
SHIFT_COLS = 3 * RWKV_C + DECAY_LORA + ICLR_LORA + GATE_LORA
IN_COLS = POOL_W + SHIFT_COLS
D_FF = ((8 * D_MODEL // 3 + 255) // 256) * 256
RMS_EPS = 1e-6
GN_EPS = 64e-5

kernel_name = "hybrid_pool_rwkv7_adaln_block"


def _rmsnorm(x, g):
    xf = x.astype(jnp.float32)
    y = xf * lax.rsqrt(jnp.mean(xf * xf, axis=-1, keepdims=True) + RMS_EPS)
    return (y * g.astype(jnp.float32)).astype(x.dtype)


def _modulate(h, shift, scale):
    return h * (1.0 + scale[:, None, :]) + shift[:, None, :]


def _token_shift(z):
    return jnp.pad(z, ((0, 0), (1, 0), (0, 0)))[:, :-1]


def _pool_mixer(u, pool_w, pool_scale):
    B, T, _ = u.shape
    uf = u.astype(jnp.float32).reshape(B, T, POOL_GROUPS, POOL_GC)
    cs = jnp.cumsum(uf, axis=1)
    t = jnp.arange(T)
    pooled = []
    for gi, w in enumerate(POOL_WINDOWS):
        csg = cs[:, :, gi]
        prev = jnp.pad(csg, ((0, 0), (w, 0), (0, 0)))[:, :T]
        cnt = jnp.minimum(t + 1, w).astype(jnp.float32)[None, :, None]
        pooled.append((csg - prev) / cnt)
    d = (jnp.stack(pooled, axis=2) - uf).astype(u.dtype)
    y = jnp.einsum('btgc,gcd->btgd', d, pool_w).reshape(B, T, POOL_W)
    return y * pool_scale


def _rwkv7_step(S, inp):
    r, w, k, v, a_vec, b_vec = inp
    sa = jnp.einsum('bhij,bhj->bhi', S, a_vec)
    S = S * w[:, :, None, :] + sa[..., None] * b_vec[:, :, None, :] + v[..., None] * k[:, :, None, :]
    y = jnp.einsum('bhij,bhj->bhi', S, r)
    return S, y


def _rwkv7_mixer(z, w0, w_decay_up, a0, w_iclr_up, w_gate_up, k_k, k_a, r_k, lnx_w, lnx_b):
    B, T, _ = z.shape
    f32 = jnp.float32
    cuts = np.cumsum([RWKV_C, RWKV_C, RWKV_C, DECAY_LORA, ICLR_LORA])
    r, k, v, xw, xa, xg = jnp.split(z, [int(i) for i in cuts], axis=-1)
    w_log = -jax.nn.softplus(-(w0 + jnp.tanh(xw) @ w_decay_up)) - 0.5
    decay = jnp.exp(-jnp.exp(w_log.astype(f32)))
    a = jax.nn.sigmoid(a0 + xa @ w_iclr_up)
    g = jax.nn.sigmoid(xg) @ w_gate_up
    heads = lambda t_: t_.astype(f32).reshape(B, T, N_HEAD, HEAD_N)
    kk = heads(k * k_k)
    kk = kk / jnp.maximum(jnp.sqrt(jnp.sum(kk * kk, axis=-1, keepdims=True)), 1e-12)
    k = k * (1.0 + (a - 1.0) * k_a)
    rh, kh, vh, wh, ah = heads(r), heads(k), heads(v), heads(decay), heads(a)
    tm = lambda t_: jnp.moveaxis(t_, 1, 0)
    S0 = jnp.zeros((B, N_HEAD, HEAD_N, HEAD_N), f32)
    _, y = lax.scan(_rwkv7_step, S0, (tm(rh), tm(wh), tm(kh), tm(vh), tm(-kk), tm(kk * ah)))
    y = jnp.moveaxis(y, 0, 1)
    mu = jnp.mean(y, axis=-1, keepdims=True)
    var = jnp.mean(jnp.square(y - mu), axis=-1, keepdims=True)
    yn = ((y - mu) * lax.rsqrt(var + GN_EPS)).reshape(B, T, RWKV_C) * lnx_w + lnx_b
    bonus = jnp.sum(rh * kh * r_k.astype(f32).reshape(N_HEAD, HEAD_N), axis=-1, keepdims=True) * vh
    out = (yn + bonus.reshape(B, T, RWKV_C)) * g
    return out.astype(z.dtype)


def setup_inputs(seed: int = 0) -> dict:
    key = jax.random.key(seed)
    ks = iter(jax.random.split(key, 32))
    f32 = jnp.float32
    nrm = lambda shape, s: jax.random.normal(next(ks), shape, f32) * s
    uni = lambda shape, lo, hi: jax.random.uniform(next(ks), shape, f32, lo, hi)
    L, D, C = DEPTH, D_MODEL, RWKV_C
    return {
        "x": nrm((BATCH, SEQ, D), 1.0),
        "c": nrm((BATCH, D), 1.0),
        "ada_w": nrm((L, D, 6 * D), D ** -0.5),
        "ada_b": nrm((L, 6 * D), 0.02),
        "norm1_g": 1.0 + nrm((L, D), 0.02),
        "w_in": nrm((L, D, IN_COLS), D ** -0.5),
        "mu_shift": uni((L, SHIFT_COLS), 0.05, 0.95),
        "pool_w": nrm((L, POOL_GROUPS, POOL_GC, POOL_GC), POOL_GC ** -0.5),
        "pool_scale": 1.0 + nrm((L, POOL_W), 0.1),
        "w0": uni((L, C), -6.0, -1.0),
        "w_decay_up": nrm((L, DECAY_LORA, C), 0.5 * DECAY_LORA ** -0.5),
        "a0": nrm((L, C), 0.1),
        "w_iclr_up": nrm((L, ICLR_LORA, C), 0.5 * ICLR_LORA ** -0.5),
        "w_gate_up": nrm((L, GATE_LORA, C), GATE_LORA ** -0.5),
        "k_k": 0.85 + nrm((L, C), 0.02),
        "k_a": 1.0 + nrm((L, C), 0.02),
        "r_k": nrm((L, C), 0.1),
        "lnx_w": 1.0 + nrm((L, C), 0.02),
        "lnx_b": nrm((L, C), 0.02),
        "w_out": nrm((L, MIX_W, D), MIX_W ** -0.5),
        "norm2_g": 1.0 + nrm((L, D), 0.02),
        "w_ffn_gu": nrm((L, D, 2 * D_FF), D ** -0.5),
        "w_ffn_down": nrm((L, D_FF, D), D_FF ** -0.5),
        "final_g": 1.0 + nrm((D,), 0.02),
    }


def reference(x, c, ada_w, ada_b, norm1_g, w_in, mu_shift, pool_w, pool_scale, w0, w_decay_up, a0,
              w_iclr_up, w_gate_up, k_k, k_a, r_k, lnx_w, lnx_b, w_out, norm2_g, w_ffn_gu,
              w_ffn_down, final_g):
    c_act = jax.nn.silu(c)
    for i in range(DEPTH):
        mod = c_act @ ada_w[i] + ada_b[i]
        sh1, sc1, g1, sh2, sc2, g2 = jnp.split(mod, 6, axis=-1)
        h = _modulate(_rmsnorm(x, norm1_g[i]), sh1, sc1)
        z = h @ w_in[i]
        u_pool = z[..., :POOL_W]
        zr = z[..., POOL_W:]
        zr = zr + (_token_shift(zr) - zr) * mu_shift[i]
        y_pool = _pool_mixer(u_pool, pool_w[i], pool_scale[i])
        y_rwkv = _rwkv7_mixer(zr, w0[i], w_decay_up[i], a0[i], w_iclr_up[i], w_gate_up[i],
                              k_k[i], k_a[i], r_k[i], lnx_w[i], lnx_b[i])
        mix = jnp.concatenate([y_pool, y_rwkv], axis=-1) @ w_out[i]
        x = x + g1[:, None, :] * mix
        h2 = _modulate(_rmsnorm(x, norm2_g[i]), sh2, sc2)
        gate, up = jnp.split(h2 @ w_ffn_gu[i], 2, axis=-1)
        x = x + g2[:, None, :] * ((jax.nn.silu(gate) * up) @ w_ffn_down[i])
    return _rmsnorm(x, final_g)
```

```cpp
#include <hip/hip_runtime.h>
#include <hip/hip_cooperative_groups.h>
#include <cstdio>
namespace cg = cooperative_groups;
namespace pg8 {
#define PG8_LAS __attribute__((address_space(3)))
typedef unsigned short bf16_t;
typedef short bf16x8 __attribute__((ext_vector_type(8)));
typedef float f32x4 __attribute__((ext_vector_type(4)));
typedef unsigned u32x4 __attribute__((ext_vector_type(4)));
constexpr int BM = 256, BK = 64, HALF = 128, HTB = HALF * BK * 2  , STAGE_BYTES = 8 * HTB, NXCD = 8, WGM = 8;

__host__ __device__ __forceinline__ int lds_byte(int r, int c) { const int st = (r >> 4) * 2 + (c >> 5), rr = r & 15, cc = c & 31, ob = rr * 64 + cc * 2; return st * 1024 + (ob ^ (((ob >> 9) & 1) << 5)); }
__host__ __device__ __forceinline__ void stage_rc(int b, int& R, int& C) { const int st = b / 1024, sb = b % 1024, swz = sb ^ (((sb >> 9) & 1) << 5); R = (st >> 1) * 16 + swz / 64; C = (st & 1) * 32 + (swz % 64) / 2; }
__host__ __device__ __forceinline__ int perm32(int rho) { const int n = rho >> 4, i = rho & 15; return 8 * (i >> 2) + 4 * n + (i & 3); }

struct Unit { int pm, pn; };
struct Gemm { const bf16_t* A; const bf16_t* Bt; int M, N, K; };

struct StaticOrder {
    int nM, nN, nwg, G, c;
    __host__ __device__ void init(int M, int N, int G_, int c_) { nM = M / BM; nN = N / BM; nwg = nM * nN; G = G_; c = c_; }
    __host__ __device__ bool next(int i, Unit& u) const {
        const long L = (long)i * G + c; if (L >= nwg) return false;
        int wgid = (int)L; { const int q = nwg / NXCD, r = nwg % NXCD, xcd = wgid % NXCD, off = wgid / NXCD; wgid = (xcd < r ? xcd * (q + 1) : r * (q + 1) + (xcd - r) * q) + off; }
        const int nig = WGM * nN, gid = wgid / nig, fm = gid * WGM, gsz = (nM - fm) < WGM ? (nM - fm) : WGM;
        u.pm = fm + ((wgid % nig) % gsz); u.pn = (wgid % nig) / gsz; return true;
    }
    __device__ __forceinline__ void a_ready(const Unit&) const {}
    __device__ __forceinline__ void done(const Unit&) const {}
};
typedef float f32x2_t __attribute__((ext_vector_type(2)));
typedef __bf16 bf16x2_t __attribute__((ext_vector_type(2)));
__device__ __forceinline__ unsigned cvt_pk_bf16(float lo, float hi) { const f32x2_t v = {lo, hi}; const bf16x2_t r = __builtin_convertvector(v, bf16x2_t); return __builtin_bit_cast(unsigned, r); }

template <class Epi, class Sched, bool STAMP = false>
__device__ __forceinline__ void gemm_phase(PG8_LAS unsigned char* lds, const Gemm g, const Sched& S, const Epi& E, unsigned long long* stamps) {
    const int tid = threadIdx.x, wid = __builtin_amdgcn_readfirstlane(tid >> 6), lane = tid & 63, wr = wid >> 2, wc = wid & 3, fr = lane & 15, fq = lane >> 4;
    const int K = g.K, nt = K / BK;
    int ts_lo = 0, ts_hi = 0, nts = 0; const unsigned long long rt_entry = STAMP ? (unsigned long long)wall_clock64() : 0ull;
#define PG8_STAMP() do { if (STAMP && wid == 0 && nts < 64) { const unsigned long long _c = (unsigned long long)clock64(); \
        ts_lo = (lane == nts) ? (int)(unsigned)_c : ts_lo; ts_hi = (lane == nts) ? (int)(unsigned)(_c >> 32) : ts_hi; ++nts; } } while (0)
    PG8_STAMP();
    unsigned voffA[2], voffB[2];
#pragma unroll
    for (int i = 0; i < 2; ++i) { int R, C; stage_rc(tid * 16 + i * 8192, R, C); const int Rb = Epi::PERM ? ((R & ~31) + perm32(R & 31)) : R;
        voffA[i] = (unsigned)(R * K + C) * 2u; voffB[i] = (unsigned)(Rb * K + C) * 2u; }
    const size_t kstep = (size_t)(BK * 2);
    const size_t hstep = (size_t)HALF * K * 2;
    const size_t tstep = 2 * hstep;
    const unsigned ldsw = (unsigned)wid * 1024u;
    const int aoff = lds_byte(wr * 64 + fr, fq * 8), boff = lds_byte(wc * 32 + fr, fq * 8);
#define PG8_SA(b, h) (((b) * 2 + (h)) * HTB)
#define PG8_SB(b, h) ((4 + (b) * 2 + (h)) * HTB)
#define PG8_STAGE(bufoff, gbase, voff) do { _Pragma("unroll") for (int _i = 0; _i < 2; ++_i) \
        __builtin_amdgcn_global_load_lds((const unsigned*)((const char*)(gbase) + (voff)[_i]), (PG8_LAS unsigned*)(lds + (bufoff) + ldsw + _i * 8192), 16, 0, 0); } while (0)
#define PG8_LDA(dst, b, h) do { _Pragma("unroll") for (int m = 0; m < 4; ++m) _Pragma("unroll") for (int k = 0; k < 2; ++k) dst[m][k] = *(const PG8_LAS bf16x8*)(lds + PG8_SA(b, h) + aoff + m * 2048 + k * 1024); } while (0)
#define PG8_LDB(dst, b, h) do { _Pragma("unroll") for (int n = 0; n < 2; ++n) _Pragma("unroll") for (int k = 0; k < 2; ++k) dst[n][k] = *(const PG8_LAS bf16x8*)(lds + PG8_SB(b, h) + boff + n * 2048 + k * 1024); } while (0)
#define PG8_MMA(ai, bj, At, Bt) do { __builtin_amdgcn_s_setprio(1); _Pragma("unroll") for (int m = 0; m < 4; ++m) _Pragma("unroll") for (int n = 0; n < 2; ++n) _Pragma("unroll") for (int k = 0; k < 2; ++k) \
        acc[ai][bj][m][n] = __builtin_amdgcn_mfma_f32_16x16x32_bf16(Bt[n][k], At[m][k], acc[ai][bj][m][n], 0, 0, 0); __builtin_amdgcn_s_setprio(0); } while (0)
#define PG8_WAIT_V(n) asm volatile("s_waitcnt vmcnt(" #n ")" ::: "memory")
#define PG8_WAIT_L(n) asm volatile("s_waitcnt lgkmcnt(" #n ")" ::: "memory")
#define PG8_BAR __builtin_amdgcn_s_barrier()
#define PG8_SCHED __builtin_amdgcn_sched_barrier(0)
    Unit cur, nxt; int ui = 0;
    if (!S.next(0, cur)) return;
    f32x4 acc[2][2][4][2];
#pragma unroll
    for (int a = 0; a < 2; ++a)
#pragma unroll
        for (int b = 0; b < 2; ++b)
#pragma unroll
            for (int m = 0; m < 4; ++m)
#pragma unroll
                for (int n = 0; n < 2; ++n) acc[a][b][m][n] = (f32x4){0.f, 0.f, 0.f, 0.f};
    bf16x8 At[4][2], B0[2][2], B1[2][2];
    const char* cA = (const char*)g.A + (size_t)cur.pm * tstep; const char* cB = (const char*)g.Bt + (size_t)cur.pn * tstep;
    S.a_ready(cur);
    PG8_STAGE(PG8_SB(0, 0), cB, voffB); PG8_STAGE(PG8_SA(0, 0), cA, voffA); PG8_STAGE(PG8_SB(0, 1), cB + hstep, voffB); PG8_STAGE(PG8_SA(0, 1), cA + hstep, voffA);
    if (wr == 1) PG8_BAR;
    PG8_WAIT_V(4); PG8_BAR;
    PG8_STAGE(PG8_SB(1, 0), cB + kstep, voffB); PG8_STAGE(PG8_SA(1, 0), cA + kstep, voffA); PG8_STAGE(PG8_SB(1, 1), cB + hstep + kstep, voffB);
    PG8_WAIT_V(6); PG8_BAR;
    PG8_STAMP();
    for (;;) {
        const bool has_next = S.next(ui + 1, nxt);
        const char* nA = has_next ? (const char*)g.A + (size_t)nxt.pm * tstep : cA; const char* nB = has_next ? (const char*)g.Bt + (size_t)nxt.pn * tstep : cB;
        for (int t = 0; t < nt; t += 2) {
            const bool last = (t == nt - 2);
            const char* a1 = cA + (size_t)(t + 1) * kstep;
            const char* a2 = last ? nA : cA + (size_t)(t + 2) * kstep; const char* b2 = last ? nB : cB + (size_t)(t + 2) * kstep;
            const char* a3 = a2 + kstep; const char* b3 = b2 + kstep;
            if (last && has_next) S.a_ready(nxt);
            PG8_LDB(B0, 0, 0); PG8_SCHED; PG8_LDA(At, 0, 0); PG8_STAGE(PG8_SA(1, 1), a1 + hstep, voffA);
            PG8_WAIT_L(8); PG8_BAR; PG8_WAIT_L(0); PG8_MMA(0, 0, At, B0); PG8_BAR; PG8_SCHED;
            PG8_LDB(B1, 0, 1); PG8_STAGE(PG8_SB(0, 0), b2, voffB);
            PG8_BAR; PG8_WAIT_L(0); PG8_MMA(0, 1, At, B1); PG8_BAR;
            PG8_LDA(At, 0, 1); PG8_STAGE(PG8_SA(0, 0), a2, voffA);
            PG8_BAR; PG8_WAIT_L(0); PG8_MMA(1, 0, At, B0); PG8_BAR; PG8_SCHED;
            PG8_STAGE(PG8_SB(0, 1), b2 + hstep, voffB);
            PG8_WAIT_V(6); PG8_BAR; PG8_MMA(1, 1, At, B1); PG8_BAR;
            PG8_LDB(B0, 1, 0); PG8_SCHED; PG8_LDA(At, 1, 0); PG8_STAGE(PG8_SA(0, 1), a2 + hstep, voffA);
            PG8_WAIT_L(8); PG8_BAR; PG8_WAIT_L(0); PG8_MMA(0, 0, At, B0); PG8_BAR; PG8_SCHED;
            PG8_LDB(B1, 1, 1); PG8_STAGE(PG8_SB(1, 0), b3, voffB);
            PG8_BAR; PG8_WAIT_L(0); PG8_MMA(0, 1, At, B1); PG8_BAR;
            PG8_LDA(At, 1, 1); PG8_STAGE(PG8_SA(1, 0), a3, voffA);
            PG8_BAR; PG8_WAIT_L(0); PG8_MMA(1, 0, At, B0); PG8_BAR; PG8_SCHED;
            PG8_STAGE(PG8_SB(1, 1), b3 + hstep, voffB);
            PG8_WAIT_V(6); PG8_BAR; PG8_MMA(1, 1, At, B1); PG8_BAR;
        }
        PG8_STAMP();
        if constexpr (!Epi::AFTER_DRAIN) { E(acc, cur, wr, wc, fr, fq); S.done(cur); }
        PG8_STAMP();
        if (!has_next) break;
#pragma unroll
        for (int a = 0; a < 2; ++a)
#pragma unroll
            for (int b = 0; b < 2; ++b)
#pragma unroll
                for (int m = 0; m < 4; ++m)
#pragma unroll
                    for (int n = 0; n < 2; ++n) acc[a][b][m][n] = (f32x4){0.f, 0.f, 0.f, 0.f};
        cur = nxt; cA = nA; cB = nB; ++ui;
    }
    PG8_WAIT_V(0);
    if (wr == 0) PG8_BAR;
    PG8_BAR;
    if constexpr (Epi::AFTER_DRAIN) { E.fused(acc, cur, wr, wc, fr, fq, lds, wid, lane); S.done(cur); }
    PG8_STAMP();
    if (STAMP && wid == 0) { stamps[lane] = lane < nts ? (((unsigned long long)(unsigned)ts_hi << 32) | (unsigned)ts_lo) : 0ull;
        if (lane == 62) stamps[62] = rt_entry; if (lane == 63) stamps[63] = (unsigned long long)wall_clock64(); }
#undef PG8_STAMP
#undef PG8_SA
#undef PG8_SB
#undef PG8_STAGE
#undef PG8_LDA
#undef PG8_LDB
#undef PG8_MMA
#undef PG8_WAIT_V
#undef PG8_WAIT_L
#undef PG8_BAR
#undef PG8_SCHED
}
}

using pg8::bf16_t; using pg8::bf16x8; using pg8::f32x4; using pg8::u32x4; using pg8::cvt_pk_bf16;
#define LAS __attribute__((address_space(3)))
typedef unsigned u32x2 __attribute__((ext_vector_type(2)));

constexpr int MTOK = 16384, DM = 1024, INC = 2304, DFF = 2816, SEQ = 8192;
constexpr size_t MiB = 1ull << 20;
constexpr size_t WS_WIN = 0, WS_WOUT = 4718592, WS_WGU = 6815744, WS_WDN = 18350080, WS_WPOOL = 24117248, WS_WDEC = 24248320,
                 WS_WICLR = 24313856, WS_WGATE = 24379392, WS_MOD = 24510464, WS_GAM = 24559616,
                 WS_H = 24 * MiB, WS_MP = 24 * MiB, WS_P = 40 * MiB, WS_Z = 56 * MiB, WS_ACT = 56 * MiB, WS_GATE = 128 * MiB,
                 WS_BONUS = 144 * MiB, WS_HST = 160 * MiB, WS_MIX = 176 * MiB;
constexpr int LDS_BYTES = 143360;
constexpr int TS = 144;
constexpr int R_AT = 0, R_BT = 9216, R_KT = 18432, R_RT = 27648, R_VT = 36864, R_BH = 46080, R_KH = 55296, R_AAK = 64512, R_ARB = 73728, R_ARK = 82944,
              R_AAB = 92160, R_RHS = 108544;
constexpr int R_TX = R_AT, R_XA = R_BT, R_SG = R_KT  , R_WT = R_AT, R_UT = R_BT;
constexpr int R_DL = R_AAK  , R_SEG = R_ARK, R_AL = R_RHS, R_GG = R_RHS + 17408;
constexpr int FS = 272;
constexpr int RS = 544;

struct Params {
    const float *x, *c, *ada_w, *ada_b, *norm1_g, *w_in, *mu_shift, *pool_w, *pool_scale, *w0, *w_decay_up, *a0, *w_iclr_up, *w_gate_up,
                *k_k, *k_a, *r_k, *lnx_w, *lnx_b, *w_out, *norm2_g, *w_ffn_gu, *w_ffn_down, *final_g;
    float* out; unsigned char* ws;
};

__device__ __forceinline__ float bf2f(unsigned v) { return __uint_as_float(v << 16); }
__device__ __forceinline__ float wave_sum(float v) {
#pragma unroll
    for (int o = 32; o > 0; o >>= 1) v += __shfl_xor(v, o);
    return v;
}
__device__ __forceinline__ float quad_sum(float v) {
    int t = __builtin_amdgcn_update_dpp(0, __float_as_int(v), 0xB1, 0xF, 0xF, true); v += __int_as_float(t);
    t = __builtin_amdgcn_update_dpp(0, __float_as_int(v), 0x4E, 0xF, 0xF, true); v += __int_as_float(t);
    return v;
}
__device__ __forceinline__ void unpack8(u32x4 v, float (&f)[8]) {
#pragma unroll
    for (int i = 0; i < 4; ++i) { f[2 * i] = __uint_as_float(v[i] << 16); f[2 * i + 1] = __uint_as_float(v[i] & 0xffff0000u); }
}
__device__ __forceinline__ u32x4 pack8(const float (&f)[8]) { return (u32x4){cvt_pk_bf16(f[0], f[1]), cvt_pk_bf16(f[2], f[3]), cvt_pk_bf16(f[4], f[5]), cvt_pk_bf16(f[6], f[7])}; }
__device__ __forceinline__ unsigned short f2bf(float f) { return (unsigned short)(cvt_pk_bf16(f, 0.f) & 0xffffu); }

__device__ __forceinline__ f32x4 mm_lds(const LAS unsigned char* A, int sa, int m0, const LAS unsigned char* Bt, int sb, int n0, int K, int lane, f32x4 acc) {
    const LAS unsigned char* ap = A + (m0 + (lane & 15)) * sa + (lane >> 4) * 16;
    const LAS unsigned char* bp = Bt + (n0 + (lane & 15)) * sb + (lane >> 4) * 16;
#pragma unroll
    for (int k0 = 0; k0 < K; k0 += 32) {
        const bf16x8 a = *(const LAS bf16x8*)(ap + k0 * 2), b = *(const LAS bf16x8*)(bp + k0 * 2);
        acc = __builtin_amdgcn_mfma_f32_16x16x32_bf16(b, a, acc, 0, 0, 0);
    }
    return acc;
}
__device__ __forceinline__ f32x4 mm_lds_g(const LAS unsigned char* A, int sa, int m0, const unsigned char* Bt, int sb, int n0, int K, int lane, f32x4 acc) {
    const LAS unsigned char* ap = A + (m0 + (lane & 15)) * sa + (lane >> 4) * 16;
    const unsigned char* bp = Bt + (size_t)(n0 + (lane & 15)) * sb + (lane >> 4) * 16;
#pragma unroll
    for (int k0 = 0; k0 < K; k0 += 32) {
        const bf16x8 a = *(const LAS bf16x8*)(ap + k0 * 2), b = *(const bf16x8*)(bp + k0 * 2);
        acc = __builtin_amdgcn_mfma_f32_16x16x32_bf16(b, a, acc, 0, 0, 0);
    }
    return acc;
}

__device__ __forceinline__ void conv_tile(LAS float* tile, const float* W, bf16_t* Wt, int K, int N, int kt, int nt, int mode) {
    const int tid = threadIdx.x, k0 = kt * 64, n0 = nt * 64;
    const int r = tid >> 4, c4 = (tid & 15) * 4;
#pragma unroll
    for (int i = 0; i < 2; ++i) { const int rr = r + 32 * i; const float4 v = *(const float4*)(W + (size_t)(k0 + rr) * N + n0 + c4);
        tile[rr * 65 + c4 + 0] = v.x; tile[rr * 65 + c4 + 1] = v.y; tile[rr * 65 + c4 + 2] = v.z; tile[rr * 65 + c4 + 3] = v.w; }
    __syncthreads();
    const int n = tid >> 3, k8 = (tid & 7) * 8;
    float f[8];
#pragma unroll
    for (int j = 0; j < 8; ++j) f[j] = tile[(k8 + j) * 65 + n];
    const int col = n0 + n; int drow = col;
    if (mode == 1) drow = col < DFF ? (col / 128) * 256 + (col % 128) : ((col - DFF) / 128) * 256 + 128 + ((col - DFF) % 128);
    *(u32x4*)(Wt + (size_t)drow * K + k0 + k8) = pack8(f);
    __syncthreads();
}
__device__ __forceinline__ void mod_unit(LAS float* red, const Params& p, int u) {
    const int tid = threadIdx.x, w = tid >> 6, lane = tid & 63, n = u * 64 + lane;
    float a0 = 0.f, a1 = 0.f;
#pragma unroll 8
    for (int k = w * 128; k < w * 128 + 128; ++k) {
        const float wv = p.ada_w[(size_t)k * 6144 + n]; const float c0 = p.c[k], c1 = p.c[1024 + k];
        a0 += (c0 / (1.f + __expf(-c0))) * wv; a1 += (c1 / (1.f + __expf(-c1))) * wv;
    }
    red[(w * 2 + 0) * 64 + lane] = a0; red[(w * 2 + 1) * 64 + lane] = a1;
    __syncthreads();
    if (tid < 128) { const int b = tid >> 6; float s = 0.f;
#pragma unroll
        for (int w2 = 0; w2 < 8; ++w2) s += red[(w2 * 2 + b) * 64 + lane];
        ((float*)(p.ws + WS_MOD))[b * 6144 + n] = s + p.ada_b[n]; }
    __syncthreads();
}
__device__ void phase0(LAS unsigned char* lds, const Params& p) {
    if (blockIdx.x < 96) mod_unit((LAS float*)lds, p, blockIdx.x);
    for (int t = (int)blockIdx.x; t < 2992; t += (int)gridDim.x) {
        const float* src; bf16_t* dst; int K, N, mode = 0, loc;
        if (t < 576) { loc = t; src = p.w_in; dst = (bf16_t*)(p.ws + WS_WIN); K = 1024; N = INC; }
        else if (t < 832) { loc = t - 576; src = p.w_out; dst = (bf16_t*)(p.ws + WS_WOUT); K = 1024; N = 1024; }
        else if (t < 2240) { loc = t - 832; src = p.w_ffn_gu; dst = (bf16_t*)(p.ws + WS_WGU); K = 1024; N = 2 * DFF; mode = 1; }
        else if (t < 2944) { loc = t - 2240; src = p.w_ffn_down; dst = (bf16_t*)(p.ws + WS_WDN); K = DFF; N = 1024; }
        else if (t < 2960) { const int g = (t - 2944) >> 2; loc = (t - 2944) & 3; src = p.pool_w + g * 16384; dst = (bf16_t*)(p.ws + WS_WPOOL) + g * 16384; K = 128; N = 128; }
        else if (t < 2968) { loc = t - 2960; src = p.w_decay_up; dst = (bf16_t*)(p.ws + WS_WDEC); K = 64; N = 512; }
        else if (t < 2976) { loc = t - 2968; src = p.w_iclr_up; dst = (bf16_t*)(p.ws + WS_WICLR); K = 64; N = 512; }
        else { loc = t - 2976; src = p.w_gate_up; dst = (bf16_t*)(p.ws + WS_WGATE); K = 128; N = 512; }
        const int ntn = N / 64;
        conv_tile((LAS float*)lds, src, dst, K, N, loc / ntn, loc % ntn, mode);
    }
}

__device__ void phase_norm(const float* X, const float* g, const float* mod, int sh_off, int sc_off, bf16_t* H) {
    const int wid = threadIdx.x >> 6, lane = threadIdx.x & 63;
    for (int row = (int)blockIdx.x * 8 + wid; row < MTOK; row += (int)gridDim.x * 8) {
        const int b = row >> 13; const float* xr = X + (size_t)row * DM; const float* mb = mod + b * 6144;
        float4 v[4]; float ss = 0.f;
#pragma unroll
        for (int j = 0; j < 4; ++j) { v[j] = *(const float4*)(xr + (j * 64 + lane) * 4); ss += v[j].x * v[j].x + v[j].y * v[j].y + v[j].z * v[j].z + v[j].w * v[j].w; }
        ss = wave_sum(ss); const float rstd = rsqrtf(ss * (1.f / 1024.f) + 1e-6f);
#pragma unroll
        for (int j = 0; j < 4; ++j) { const int col = (j * 64 + lane) * 4;
            const float4 gg = *(const float4*)(g + col), sc = *(const float4*)(mb + sc_off + col), sh = *(const float4*)(mb + sh_off + col);
            const float h0 = (v[j].x * rstd * gg.x) * (1.f + sc.x) + sh.x, h1 = (v[j].y * rstd * gg.y) * (1.f + sc.y) + sh.y,
                        h2 = (v[j].z * rstd * gg.z) * (1.f + sc.z) + sh.z, h3 = (v[j].w * rstd * gg.w) * (1.f + sc.w) + sh.w;
            *(u32x2*)(H + (size_t)row * DM + col) = (u32x2){cvt_pk_bf16(h0, h1), cvt_pk_bf16(h2, h3)}; }
    }
}
__device__ void phase_final(float* X, const float* g) {
    const int wid = threadIdx.x >> 6, lane = threadIdx.x & 63;
    for (int row = (int)blockIdx.x * 8 + wid; row < MTOK; row += (int)gridDim.x * 8) {
        float* xr = X + (size_t)row * DM;
        float4 v[4]; float ss = 0.f;
#pragma unroll
        for (int j = 0; j < 4; ++j) { v[j] = *(const float4*)(xr + (j * 64 + lane) * 4); ss += v[j].x * v[j].x + v[j].y * v[j].y + v[j].z * v[j].z + v[j].w * v[j].w; }
        ss = wave_sum(ss); const float rstd = rsqrtf(ss * (1.f / 1024.f) + 1e-6f);
#pragma unroll
        for (int j = 0; j < 4; ++j) { const int col = (j * 64 + lane) * 4; const float4 gg = *(const float4*)(g + col);
            *(float4*)(xr + col) = make_float4(v[j].x * rstd * gg.x, v[j].y * rstd * gg.y, v[j].z * rstd * gg.z, v[j].w * rstd * gg.w); }
    }
}

struct EpiZ {
    static constexpr bool PERM = true, AFTER_DRAIN = false;
    bf16_t* O; int ldc;
    __device__ __forceinline__ void operator()(const f32x4 (&acc)[2][2][4][2], const pg8::Unit& u, int wr, int wc, int fr, int fq) const {
        const int row0 = u.pm * 256 + wr * 64 + fr, col0 = u.pn * 256 + wc * 32 + 8 * fq;
#pragma unroll
        for (int ai = 0; ai < 2; ++ai)
#pragma unroll
            for (int m = 0; m < 4; ++m) { bf16_t* rowp = O + (size_t)(row0 + ai * 128 + m * 16) * ldc + col0;
#pragma unroll
                for (int bj = 0; bj < 2; ++bj) { const f32x4 v0 = acc[ai][bj][m][0], v1 = acc[ai][bj][m][1];
                    *(u32x4*)(rowp + bj * 128) = (u32x4){cvt_pk_bf16(v0[0], v0[1]), cvt_pk_bf16(v0[2], v0[3]), cvt_pk_bf16(v1[0], v1[1]), cvt_pk_bf16(v1[2], v1[3])}; } }
    }
};
struct EpiRes {
    static constexpr bool PERM = false, AFTER_DRAIN = false;
    const float* xin; float* out; const float* gate;
    __device__ __forceinline__ void operator()(const f32x4 (&acc)[2][2][4][2], const pg8::Unit& u, int wr, int wc, int fr, int fq) const {
        const int row0 = u.pm * 256 + wr * 64 + fr, col0 = u.pn * 256 + wc * 32 + 4 * fq;
        const float* gb = gate + (u.pm >> 5) * 6144;
        f32x4 gv[2][2];
#pragma unroll
        for (int bj = 0; bj < 2; ++bj)
#pragma unroll
            for (int n = 0; n < 2; ++n) gv[bj][n] = *(const f32x4*)(gb + col0 + bj * 128 + n * 16);
#pragma unroll
        for (int ai = 0; ai < 2; ++ai)
#pragma unroll
            for (int m = 0; m < 4; ++m) { const size_t ro = (size_t)(row0 + ai * 128 + m * 16) * DM + col0;
#pragma unroll
                for (int bj = 0; bj < 2; ++bj)
#pragma unroll
                    for (int n = 0; n < 2; ++n) { const f32x4 xv = *(const f32x4*)(xin + ro + bj * 128 + n * 16);
                        *(f32x4*)(out + ro + bj * 128 + n * 16) = xv + gv[bj][n] * acc[ai][bj][m][n]; } }
    }
};
struct EpiAct {
    static constexpr bool PERM = true, AFTER_DRAIN = false;
    bf16_t* O;
    __device__ __forceinline__ void operator()(const f32x4 (&acc)[2][2][4][2], const pg8::Unit& u, int wr, int wc, int fr, int fq) const {
        const int row0 = u.pm * 256 + wr * 64 + fr, col0 = u.pn * 128 + wc * 32 + 8 * fq;
#pragma unroll
        for (int ai = 0; ai < 2; ++ai)
#pragma unroll
            for (int m = 0; m < 4; ++m) { float r[8];
#pragma unroll
                for (int n = 0; n < 2; ++n)
#pragma unroll
                    for (int e = 0; e < 4; ++e) { const float gt = acc[ai][0][m][n][e], up = acc[ai][1][m][n][e]; r[n * 4 + e] = gt / (1.f + __expf(-gt)) * up; }
                *(u32x4*)(O + (size_t)(row0 + ai * 128 + m * 16) * DFF + col0) = pack8(r); }
    }
};
template <class Epi> __device__ __forceinline__ void run_gemm(LAS unsigned char* lds, const bf16_t* A, const bf16_t* Bt, int N, int K, const Epi& E) {
    pg8::Gemm g; g.A = A; g.Bt = Bt; g.M = MTOK; g.N = N; g.K = K;
    pg8::StaticOrder S; S.init(MTOK, N, (int)gridDim.x, (int)blockIdx.x);
    pg8::gemm_phase<Epi, pg8::StaticOrder, false>(lds, g, S, E, nullptr);
}

__device__ void pool_item(LAS unsigned char* lds, const Params& p, int tt, int g) {
    const int tid = threadIdx.x, t = tid >> 3, cgp = tid & 7, wid = tid >> 6, lane = tid & 63;
    const bf16_t* Z = (const bf16_t*)(p.ws + WS_Z);
    const int row = tt * 64 + t, tl = row & (SEQ - 1), w = 2 << g, cnt = (tl + 1) < w ? (tl + 1) : w;
    const bf16_t* zp = Z + (size_t)row * INC + g * 128 + cgp * 16;
    float s[16], u0[16];
    { float a[8], b[8]; unpack8(*(const u32x4*)zp, a); unpack8(*(const u32x4*)(zp + 8), b);
#pragma unroll
      for (int e = 0; e < 8; ++e) { u0[e] = a[e]; u0[8 + e] = b[e]; s[e] = a[e]; s[8 + e] = b[e]; } }
    for (int q = 1; q < cnt; ++q) { float a[8], b[8]; unpack8(*(const u32x4*)(zp - (size_t)q * INC), a); unpack8(*(const u32x4*)(zp - (size_t)q * INC + 8), b);
#pragma unroll
        for (int e = 0; e < 8; ++e) { s[e] += a[e]; s[8 + e] += b[e]; } }
    const float inv = 1.f / (float)cnt;
    float d0[8], d1[8];
#pragma unroll
    for (int e = 0; e < 8; ++e) { d0[e] = s[e] * inv - u0[e]; d1[e] = s[8 + e] * inv - u0[8 + e]; }
    *(LAS u32x4*)(lds + t * 272 + cgp * 32) = pack8(d0); *(LAS u32x4*)(lds + t * 272 + cgp * 32 + 16) = pack8(d1);
    __syncthreads();
    const unsigned char* Bt = p.ws + WS_WPOOL + (size_t)g * 32768;
    const float4 ps = *(const float4*)(p.pool_scale + g * 128 + wid * 16 + 4 * (lane >> 4));
    bf16_t* mix = (bf16_t*)(p.ws + WS_MIX);
#pragma unroll
    for (int m = 0; m < 4; ++m) {
        f32x4 acc = {0.f, 0.f, 0.f, 0.f};
        acc = mm_lds_g(lds, 272, m * 16, Bt, 256, wid * 16, 128, lane, acc);
        const int orow = tt * 64 + m * 16 + (lane & 15), ocol = g * 128 + wid * 16 + 4 * (lane >> 4);
        *(u32x2*)(mix + (size_t)orow * DM + ocol) = (u32x2){cvt_pk_bf16(acc[0] * ps.x, acc[1] * ps.y), cvt_pk_bf16(acc[2] * ps.z, acc[3] * ps.w)};
    }
    __syncthreads();
}

__device__ __forceinline__ void shifted8(const bf16_t* Z, int row, bool has_prev, int col, const float* mu_shift, float (&o)[8]) {
    float cur[8], prv[8];
    unpack8(*(const u32x4*)(Z + (size_t)row * INC + col), cur);
    if (has_prev) unpack8(*(const u32x4*)(Z + (size_t)(row - 1) * INC + col), prv);
    else {
#pragma unroll
        for (int e = 0; e < 8; ++e) prv[e] = 0.f; }
    const float4 m0 = *(const float4*)(mu_shift + col - 512), m1 = *(const float4*)(mu_shift + col - 512 + 4);
    const float mu[8] = {m0.x, m0.y, m0.z, m0.w, m1.x, m1.y, m1.z, m1.w};
#pragma unroll
    for (int e = 0; e < 8; ++e) o[e] = cur[e] + (prv[e] - cur[e]) * mu[e];
}
__device__ void scan_pre_item(LAS unsigned char* lds, const Params& p, int item) {
    const int tid = threadIdx.x, t = tid >> 3, jg = tid & 7, wid = tid >> 6, lane = tid & 63;
    const int h = item & 7, c = (item >> 3) & 127, b = item >> 10;
    const bf16_t* Z = (const bf16_t*)(p.ws + WS_Z);
    const int row = b * SEQ + c * 64 + t; const bool has_prev = (c * 64 + t) > 0;
    const int hc = h * 64 + jg * 8;
    float r8[8], k8[8], v8[8];
    shifted8(Z, row, has_prev, 512 + hc, p.mu_shift, r8);
    shifted8(Z, row, has_prev, 1024 + hc, p.mu_shift, k8);
    shifted8(Z, row, has_prev, 1536 + hc, p.mu_shift, v8);
    { float f[8];
      shifted8(Z, row, has_prev, 2048 + jg * 8, p.mu_shift, f);
#pragma unroll
      for (int e = 0; e < 8; ++e) f[e] = tanhf(f[e]);
      *(LAS u32x4*)(lds + R_TX + t * TS + jg * 16) = pack8(f);
      shifted8(Z, row, has_prev, 2112 + jg * 8, p.mu_shift, f);
      *(LAS u32x4*)(lds + R_XA + t * TS + jg * 16) = pack8(f);
#pragma unroll
      for (int hh = 0; hh < 2; ++hh) { shifted8(Z, row, has_prev, 2176 + jg * 16 + hh * 8, p.mu_shift, f);
#pragma unroll
          for (int e = 0; e < 8; ++e) f[e] = 1.f / (1.f + __expf(-f[e]));
          *(LAS u32x4*)(lds + R_SG + t * 272 + jg * 32 + hh * 16) = pack8(f); } }
    __syncthreads();
    { const int m = wid >> 1;
#pragma unroll
      for (int nn = 0; nn < 2; ++nn) { const int n = (wid & 1) * 2 + nn;
          f32x4 a0 = {0.f, 0.f, 0.f, 0.f}, a1 = a0, a2 = a0;
          a0 = mm_lds_g(lds + R_TX, TS, m * 16, p.ws + WS_WDEC + (size_t)h * 64 * 128, 128, n * 16, 64, lane, a0);
          a1 = mm_lds_g(lds + R_XA, TS, m * 16, p.ws + WS_WICLR + (size_t)h * 64 * 128, 128, n * 16, 64, lane, a1);
          a2 = mm_lds_g(lds + R_SG, 272, m * 16, p.ws + WS_WGATE + (size_t)h * 64 * 256, 256, n * 16, 128, lane, a2);
          const int off = (m * 16 + (lane & 15)) * FS + (n * 16 + 4 * (lane >> 4)) * 4;
          *(LAS f32x4*)(lds + R_DL + off) = a0; *(LAS f32x4*)(lds + R_AL + off) = a1; *(LAS f32x4*)(lds + R_GG + off) = a2; } }
    __syncthreads();
    float av8[8], bv8[8];
    { float dl[8], al[8], gg[8];
      { const f32x4 x0 = *(const LAS f32x4*)(lds + R_DL + t * FS + jg * 32), x1 = *(const LAS f32x4*)(lds + R_DL + t * FS + jg * 32 + 16);
        const f32x4 y0 = *(const LAS f32x4*)(lds + R_AL + t * FS + jg * 32), y1 = *(const LAS f32x4*)(lds + R_AL + t * FS + jg * 32 + 16);
        const f32x4 z0 = *(const LAS f32x4*)(lds + R_GG + t * FS + jg * 32), z1 = *(const LAS f32x4*)(lds + R_GG + t * FS + jg * 32 + 16);
#pragma unroll
        for (int e = 0; e < 4; ++e) { dl[e] = x0[e]; dl[4 + e] = x1[e]; al[e] = y0[e]; al[4 + e] = y1[e]; gg[e] = z0[e]; gg[4 + e] = z1[e]; } }
      float w0v[8], a0v[8], kkv[8], kav[8], rkv[8];
      { const float4 q0 = *(const float4*)(p.w0 + hc), q1 = *(const float4*)(p.w0 + hc + 4); w0v[0] = q0.x; w0v[1] = q0.y; w0v[2] = q0.z; w0v[3] = q0.w; w0v[4] = q1.x; w0v[5] = q1.y; w0v[6] = q1.z; w0v[7] = q1.w; }
      { const float4 q0 = *(const float4*)(p.a0 + hc), q1 = *(const float4*)(p.a0 + hc + 4); a0v[0] = q0.x; a0v[1] = q0.y; a0v[2] = q0.z; a0v[3] = q0.w; a0v[4] = q1.x; a0v[5] = q1.y; a0v[6] = q1.z; a0v[7] = q1.w; }
      { const float4 q0 = *(const float4*)(p.k_k + hc), q1 = *(const float4*)(p.k_k + hc + 4); kkv[0] = q0.x; kkv[1] = q0.y; kkv[2] = q0.z; kkv[3] = q0.w; kkv[4] = q1.x; kkv[5] = q1.y; kkv[6] = q1.z; kkv[7] = q1.w; }
      { const float4 q0 = *(const float4*)(p.k_a + hc), q1 = *(const float4*)(p.k_a + hc + 4); kav[0] = q0.x; kav[1] = q0.y; kav[2] = q0.z; kav[3] = q0.w; kav[4] = q1.x; kav[5] = q1.y; kav[6] = q1.z; kav[7] = q1.w; }
      { const float4 q0 = *(const float4*)(p.r_k + hc), q1 = *(const float4*)(p.r_k + hc + 4); rkv[0] = q0.x; rkv[1] = q0.y; rkv[2] = q0.z; rkv[3] = q0.w; rkv[4] = q1.x; rkv[5] = q1.y; rkv[6] = q1.z; rkv[7] = q1.w; }
      float ld[8], aa[8], kk[8]; float ssq = 0.f;
#pragma unroll
      for (int e = 0; e < 8; ++e) {
          const float xx = w0v[e] + dl[e];
          const float sp = fmaxf(-xx, 0.f) + log1pf(__expf(-fabsf(xx)));
          ld[e] = -__expf(-sp - 0.5f);
          aa[e] = 1.f / (1.f + __expf(-(a0v[e] + al[e])));
          kk[e] = k8[e] * kkv[e]; ssq += kk[e] * kk[e];
      }
      ssq += __shfl_xor(ssq, 1); ssq += __shfl_xor(ssq, 2); ssq += __shfl_xor(ssq, 4);
      const float kinv = 1.f / fmaxf(sqrtf(ssq), 1e-12f);
      float bon = 0.f;
#pragma unroll
      for (int e = 0; e < 8; ++e) { kk[e] *= kinv; k8[e] = k8[e] * (1.f + (aa[e] - 1.f) * kav[e]); bon += r8[e] * k8[e] * rkv[e]; av8[e] = -kk[e]; bv8[e] = kk[e] * aa[e]; }
      bon += __shfl_xor(bon, 1); bon += __shfl_xor(bon, 2); bon += __shfl_xor(bon, 4);
      float bv[8];
#pragma unroll
      for (int e = 0; e < 8; ++e) bv[e] = bon * v8[e];
      const size_t go = (size_t)item * 4096 + t * 64 + jg * 8;
      *(u32x4*)((bf16_t*)(p.ws + WS_GATE) + go) = pack8(gg);
      *(u32x4*)((bf16_t*)(p.ws + WS_BONUS) + go) = pack8(bv);
      *(LAS f32x4*)(lds + R_DL + t * FS + jg * 32) = (f32x4){ld[0], ld[1], ld[2], ld[3]};
      *(LAS f32x4*)(lds + R_DL + t * FS + jg * 32 + 16) = (f32x4){ld[4], ld[5], ld[6], ld[7]};
    }
    __syncthreads();
    { const int j = tid & 63, seg = tid >> 6; float run = 0.f;
#pragma unroll
      for (int i = 0; i < 8; ++i) { LAS float* q = (LAS float*)(lds + R_DL + (seg * 8 + i) * FS + j * 4); run += *q; *q = run; }
      *(LAS float*)(lds + R_SEG + (seg * 64 + j) * 4) = run;
      __syncthreads();
      float pre = 0.f;
      for (int s2 = 0; s2 < seg; ++s2) pre += *(const LAS float*)(lds + R_SEG + (s2 * 64 + j) * 4);
#pragma unroll
      for (int i = 0; i < 8; ++i) { LAS float* q = (LAS float*)(lds + R_DL + (seg * 8 + i) * FS + j * 4); *q += pre; } }
    __syncthreads();
    { float L[8], Lp[8], LC[8];
      { const f32x4 x0 = *(const LAS f32x4*)(lds + R_DL + t * FS + jg * 32), x1 = *(const LAS f32x4*)(lds + R_DL + t * FS + jg * 32 + 16);
        const f32x4 c0 = *(const LAS f32x4*)(lds + R_DL + 63 * FS + jg * 32), c1 = *(const LAS f32x4*)(lds + R_DL + 63 * FS + jg * 32 + 16);
        f32x4 p0 = {0.f, 0.f, 0.f, 0.f}, p1 = p0;
        if (t > 0) { p0 = *(const LAS f32x4*)(lds + R_DL + (t - 1) * FS + jg * 32); p1 = *(const LAS f32x4*)(lds + R_DL + (t - 1) * FS + jg * 32 + 16); }
#pragma unroll
        for (int e = 0; e < 4; ++e) { L[e] = x0[e]; L[4 + e] = x1[e]; LC[e] = c0[e]; LC[4 + e] = c1[e]; Lp[e] = p0[e]; Lp[4 + e] = p1[e]; } }
      float at[8], bt[8], kt[8], rt[8];
#pragma unroll
      for (int e = 0; e < 8; ++e) {
          const float eL = __expf(L[e]), eLp = __expf(Lp[e]), einv = __expf(-L[e]), eC = __expf(LC[e] - L[e]);
          at[e] = av8[e] * eLp; bt[e] = bv8[e] * einv; kt[e] = k8[e] * einv; rt[e] = r8[e] * eL;
          const int ch = jg * 8 + e;
          *(LAS unsigned short*)(lds + R_VT + ch * TS + t * 2) = f2bf(v8[e]);
          *(LAS unsigned short*)(lds + R_BH + ch * TS + t * 2) = f2bf(bv8[e] * eC);
          *(LAS unsigned short*)(lds + R_KH + ch * TS + t * 2) = f2bf(k8[e] * eC);
          if (t == 63) ((float*)(p.ws + WS_GAM))[(size_t)item * 64 + ch] = __expf(LC[e]);
      }
      *(LAS f32x4*)(lds + R_RHS + t * RS + jg * 32) = (f32x4){at[0], at[1], at[2], at[3]};
      *(LAS f32x4*)(lds + R_RHS + t * RS + jg * 32 + 16) = (f32x4){at[4], at[5], at[6], at[7]};
      *(LAS u32x4*)(lds + R_AT + t * TS + jg * 16) = pack8(at);
      *(LAS u32x4*)(lds + R_BT + t * TS + jg * 16) = pack8(bt);
      *(LAS u32x4*)(lds + R_KT + t * TS + jg * 16) = pack8(kt);
      *(LAS u32x4*)(lds + R_RT + t * TS + jg * 16) = pack8(rt);
    }
    __syncthreads();
    { const int mat = wid >> 1;
      const LAS unsigned char* Aop = lds + ((mat < 2) ? R_AT : R_RT);
      const LAS unsigned char* Bop = lds + ((mat & 1) ? R_KT : R_BT);
      const int incl = (mat >= 2) ? 1 : 0;
#pragma unroll
      for (int mm = 0; mm < 2; ++mm) { const int m = (wid & 1) * 2 + mm;
#pragma unroll
          for (int n = 0; n < 4; ++n) {
              f32x4 acc = {0.f, 0.f, 0.f, 0.f};
              if (n <= m) acc = mm_lds(Aop, TS, m * 16, Bop, TS, n * 16, 64, lane, acc);
              const int tr = m * 16 + (lane & 15), s0 = n * 16 + 4 * (lane >> 4);
#pragma unroll
              for (int e = 0; e < 4; ++e) if (!(s0 + e < tr + incl)) acc[e] = 0.f;
              if (mat == 0) {
#pragma unroll
                  for (int e = 0; e < 4; ++e) *(LAS float*)(lds + R_AAB + (tr * 64 + e * 16 + n * 4 + (lane >> 4)) * 4) = acc[e];
              } else {
                  const int dst = (mat == 1) ? R_AAK : ((mat == 2) ? R_ARB : R_ARK);
                  *(LAS u32x2*)(lds + dst + tr * TS + s0 * 2) = (u32x2){cvt_pk_bf16(acc[0], acc[1]), cvt_pk_bf16(acc[2], acc[3])};
              }
          } } }
    __syncthreads();
    { const int m = wid >> 1;
#pragma unroll
      for (int nn = 0; nn < 2; ++nn) { const int n = (wid & 1) * 2 + nn;
          f32x4 acc = {0.f, 0.f, 0.f, 0.f};
          acc = mm_lds(lds + R_AAK, TS, m * 16, lds + R_VT, TS, n * 16, 64, lane, acc);
          *(LAS f32x4*)(lds + R_RHS + (m * 16 + (lane & 15)) * RS + (64 + n * 16 + 4 * (lane >> 4)) * 4) = acc; } }
    __syncthreads();
    { const int cc = lane >> 2, q = lane & 3, col = wid * 16 + cc;
      float ur[16];
#pragma unroll
      for (int i = 0; i < 16; ++i) ur[i] = *(const LAS float*)(lds + R_RHS + (4 * i + q) * RS + col * 4);
#pragma unroll
      for (int tt = 1; tt < 64; ++tt) {
          const int nI = (tt + 3) >> 2;
          const LAS unsigned char* ar = lds + R_AAB + (tt * 64 + q * 16) * 4;
          float pp = 0.f;
#pragma unroll
          for (int i4 = 0; i4 < (nI + 3) / 4; ++i4) { const f32x4 a4 = *(const LAS f32x4*)(ar + i4 * 16);
#pragma unroll
              for (int e = 0; e < 4; ++e) if (i4 * 4 + e < nI) pp += a4[e] * ur[i4 * 4 + e]; }
          pp = quad_sum(pp);
          if (q == (tt & 3)) ur[tt >> 2] += pp;
      }
      const int dbase = (col < 64) ? (R_WT + col * TS) : (R_UT + (col - 64) * TS);
#pragma unroll
      for (int i = 0; i < 16; ++i) *(LAS unsigned short*)(lds + dbase + (4 * i + q) * 2) = f2bf(ur[i]);
    }
    __syncthreads();
    { const int o = wid >> 1;
      bf16_t* MPg = (bf16_t*)(p.ws + WS_MP) + (size_t)item * 4096; bf16_t* Pg = (bf16_t*)(p.ws + WS_P) + (size_t)item * 4096;
      float* Qg = p.out + (size_t)item * 4096; float* GTg = p.out + 8388608 + (size_t)item * 4096;
#pragma unroll
      for (int mm = 0; mm < 2; ++mm) { const int m = (wid & 1) * 2 + mm;
#pragma unroll
          for (int n = 0; n < 4; ++n) {
              f32x4 acc = {0.f, 0.f, 0.f, 0.f};
              const int rr = m * 16 + (lane & 15), c0 = n * 16 + 4 * (lane >> 4);
              if (o == 0) { acc = mm_lds(lds + R_BH, TS, m * 16, lds + R_WT, TS, n * 16, 64, lane, acc);
                  *(u32x2*)(MPg + rr * 64 + c0) = (u32x2){cvt_pk_bf16(acc[0], acc[1]), cvt_pk_bf16(acc[2], acc[3])}; }
              else if (o == 1) { acc = mm_lds(lds + R_UT, TS, m * 16, lds + R_BH, TS, n * 16, 64, lane, acc);
                  acc = mm_lds(lds + R_VT, TS, m * 16, lds + R_KH, TS, n * 16, 64, lane, acc);
                  *(f32x4*)(GTg + rr * 64 + c0) = acc; }
              else if (o == 2) { acc = mm_lds(lds + R_ARB, TS, m * 16, lds + R_WT, TS, n * 16, 64, lane, acc);
                  const u32x2 rv = *(const LAS u32x2*)(lds + R_RT + rr * TS + c0 * 2);
                  acc[0] += bf2f(rv[0] & 0xffffu); acc[1] += __uint_as_float(rv[0] & 0xffff0000u); acc[2] += bf2f(rv[1] & 0xffffu); acc[3] += __uint_as_float(rv[1] & 0xffff0000u);
                  *(u32x2*)(Pg + rr * 64 + c0) = (u32x2){cvt_pk_bf16(acc[0], acc[1]), cvt_pk_bf16(acc[2], acc[3])}; }
              else { acc = mm_lds(lds + R_ARB, TS, m * 16, lds + R_UT, TS, n * 16, 64, lane, acc);
                  acc = mm_lds(lds + R_ARK, TS, m * 16, lds + R_VT, TS, n * 16, 64, lane, acc);
                  *(f32x4*)(Qg + rr * 64 + c0) = acc; }
          } } }
    __syncthreads();
}

__device__ void phase_state(LAS unsigned char* lds, const Params& p) {
    if (blockIdx.x >= 32) return;
    const int tid = threadIdx.x, wid = tid >> 6, lane = tid & 63;
    const int bh = blockIdx.x >> 1, half = blockIdx.x & 1, b = bh >> 3, h = bh & 7;
    const int vl = wid >> 2, vb = half * 2 + vl, rb = wid & 3;
    const bf16_t* MP = (const bf16_t*)(p.ws + WS_MP); const float* GT = p.out + 8388608; const float* GAM = (const float*)(p.ws + WS_GAM);
    bf16_t* HST = (bf16_t*)(p.ws + WS_HST);
    const int arow = rb * 16 + (lane & 15), acol = 8 * (lane >> 4);
    const int irow = vb * 16 + (lane & 15), jcol = rb * 16 + 4 * (lane >> 4);
    f32x4 acc = {0.f, 0.f, 0.f, 0.f};
    size_t item = (size_t)(b * 128) * 8 + h;
    bf16x8 a0 = *(const bf16x8*)(MP + item * 4096 + arow * 64 + acol), a1 = *(const bf16x8*)(MP + item * 4096 + arow * 64 + acol + 32);
    f32x4 gt = *(const f32x4*)(GT + item * 4096 + irow * 64 + jcol), gm = *(const f32x4*)(GAM + item * 64 + jcol);
    int buf = 0;
    for (int c = 0; c < 128; ++c) {
        item = (size_t)(b * 128 + c) * 8 + h;
        const u32x2 pk = {cvt_pk_bf16(acc[0], acc[1]), cvt_pk_bf16(acc[2], acc[3])};
        *(LAS u32x2*)(lds + buf * 4608 + (vl * 16 + (lane & 15)) * TS + jcol * 2) = pk;
        *(u32x2*)(HST + item * 4096 + irow * 64 + jcol) = pk;
        const bf16x8 ca0 = a0, ca1 = a1; const f32x4 cgt = gt, cgm = gm;
        if (c + 1 < 128) { const size_t ni = item + 8;
            a0 = *(const bf16x8*)(MP + ni * 4096 + arow * 64 + acol); a1 = *(const bf16x8*)(MP + ni * 4096 + arow * 64 + acol + 32);
            gt = *(const f32x4*)(GT + ni * 4096 + irow * 64 + jcol); gm = *(const f32x4*)(GAM + ni * 64 + jcol); }
        __syncthreads();
        const bf16x8 b0 = *(const LAS bf16x8*)(lds + buf * 4608 + (vl * 16 + (lane & 15)) * TS + (lane >> 4) * 16);
        const bf16x8 b1 = *(const LAS bf16x8*)(lds + buf * 4608 + (vl * 16 + (lane & 15)) * TS + (lane >> 4) * 16 + 64);
        acc = cgm * acc + cgt;
        acc = __builtin_amdgcn_mfma_f32_16x16x32_bf16(ca0, b0, acc, 0, 0, 0);
        acc = __builtin_amdgcn_mfma_f32_16x16x32_bf16(ca1, b1, acc, 0, 0, 0);
        buf ^= 1;
    }
}

__device__ void phase_out(const Params& p) {
    const int tid = threadIdx.x, wid = tid >> 6, lane = tid & 63, sub = wid >> 2, mt = wid & 3;
    const bf16_t* Pm = (const bf16_t*)(p.ws + WS_P); const bf16_t* HST = (const bf16_t*)(p.ws + WS_HST); const float* Q = p.out;
    const bf16_t* GA = (const bf16_t*)(p.ws + WS_GATE); const bf16_t* BO = (const bf16_t*)(p.ws + WS_BONUS); bf16_t* mix = (bf16_t*)(p.ws + WS_MIX);
    for (int u = (int)blockIdx.x; u < 1024; u += (int)gridDim.x) {
        const size_t item = (size_t)u * 2 + sub; const int h = (int)(item & 7), c = (int)((item >> 3) & 127), b = (int)(item >> 10);
        const int tr = mt * 16 + (lane & 15);
        const bf16x8 a0 = *(const bf16x8*)(Pm + item * 4096 + tr * 64 + 8 * (lane >> 4)), a1 = *(const bf16x8*)(Pm + item * 4096 + tr * 64 + 8 * (lane >> 4) + 32);
        f32x4 y[4]; float s = 0.f;
#pragma unroll
        for (int n = 0; n < 4; ++n) {
            const bf16_t* hp = HST + item * 4096 + (n * 16 + (lane & 15)) * 64 + 8 * (lane >> 4);
            const bf16x8 b0 = *(const bf16x8*)hp, b1 = *(const bf16x8*)(hp + 32);
            f32x4 acc = *(const f32x4*)(Q + item * 4096 + tr * 64 + n * 16 + 4 * (lane >> 4));
            acc = __builtin_amdgcn_mfma_f32_16x16x32_bf16(b0, a0, acc, 0, 0, 0);
            acc = __builtin_amdgcn_mfma_f32_16x16x32_bf16(b1, a1, acc, 0, 0, 0);
            y[n] = acc; s += acc[0] + acc[1] + acc[2] + acc[3];
        }
        s += __shfl_xor(s, 16); s += __shfl_xor(s, 32);
        const float mu = s * (1.f / 64.f); float vs = 0.f;
#pragma unroll
        for (int n = 0; n < 4; ++n)
#pragma unroll
            for (int e = 0; e < 4; ++e) { const float d = y[n][e] - mu; vs += d * d; }
        vs += __shfl_xor(vs, 16); vs += __shfl_xor(vs, 32);
        const float rstd = rsqrtf(vs * (1.f / 64.f) + 64e-5f);
        const size_t orow = (size_t)(b * SEQ + c * 64 + tr) * DM + 512 + h * 64;
#pragma unroll
        for (int n = 0; n < 4; ++n) { const int i0 = n * 16 + 4 * (lane >> 4);
            const float4 lw = *(const float4*)(p.lnx_w + h * 64 + i0), lb = *(const float4*)(p.lnx_b + h * 64 + i0);
            const u32x2 gv = *(const u32x2*)(GA + item * 4096 + tr * 64 + i0), bv = *(const u32x2*)(BO + item * 4096 + tr * 64 + i0);
            const float g0 = bf2f(gv[0] & 0xffffu), g1 = __uint_as_float(gv[0] & 0xffff0000u), g2 = bf2f(gv[1] & 0xffffu), g3 = __uint_as_float(gv[1] & 0xffff0000u);
            const float o0 = bf2f(bv[0] & 0xffffu), o1 = __uint_as_float(bv[0] & 0xffff0000u), o2 = bf2f(bv[1] & 0xffffu), o3 = __uint_as_float(bv[1] & 0xffff0000u);
            const float r0 = ((y[n][0] - mu) * rstd * lw.x + lb.x + o0) * g0, r1 = ((y[n][1] - mu) * rstd * lw.y + lb.y + o1) * g1,
                        r2 = ((y[n][2] - mu) * rstd * lw.z + lb.z + o2) * g2, r3 = ((y[n][3] - mu) * rstd * lw.w + lb.w + o3) * g3;
            *(u32x2*)(mix + orow + i0) = (u32x2){cvt_pk_bf16(r0, r1), cvt_pk_bf16(r2, r3)}; }
    }
}


#ifndef DIAG
#define DIAG 0
#endif
__device__ void dump_bf16(const bf16_t* src, int ld, int coff, float* out) {
    for (size_t i = (size_t)blockIdx.x * 512 + threadIdx.x; i < (size_t)MTOK * DM; i += (size_t)gridDim.x * 512) {
        const size_t r = i >> 10, c = i & 1023; float v = bf2f(src[r * ld + coff + c]); if (!(v == v) || fabsf(v) > 1e30f) v = 7777.f; out[i] = v; }
}
__global__ void __launch_bounds__(512, 2) fwd_megakernel(Params p) {
    extern __shared__ __attribute__((aligned(16))) unsigned char shm[];
    LAS unsigned char* lds = (LAS unsigned char*)shm;
    cg::grid_group grid = cg::this_grid();
#define GSYNC() do { asm volatile("s_waitcnt vmcnt(0) lgkmcnt(0)" ::: "memory"); __syncthreads(); grid.sync(); } while (0)
    float* mod = (float*)(p.ws + WS_MOD);
    phase0(lds, p);
    GSYNC();
    phase_norm(p.x, p.norm1_g, mod, 0, 1024, (bf16_t*)(p.ws + WS_H));
    GSYNC();
    { EpiZ e; e.O = (bf16_t*)(p.ws + WS_Z); e.ldc = INC; run_gemm(lds, (const bf16_t*)(p.ws + WS_H), (const bf16_t*)(p.ws + WS_WIN), INC, 1024, e); }
    GSYNC();
    if (DIAG == 2) { dump_bf16((const bf16_t*)(p.ws + WS_Z), INC, 0, p.out); return; }
    if (DIAG == 3) { dump_bf16((const bf16_t*)(p.ws + WS_Z), INC, 1024, p.out); return; }
    for (int it = (int)blockIdx.x; it < 2048; it += (int)gridDim.x) scan_pre_item(lds, p, it);
    for (int it = (int)blockIdx.x; it < 1024; it += (int)gridDim.x) pool_item(lds, p, it >> 2, it & 3);
    GSYNC();
    phase_state(lds, p);
    GSYNC();
    phase_out(p);
    GSYNC();
    if (DIAG == 5) { dump_bf16((const bf16_t*)(p.ws + WS_MIX), DM, 0, p.out); return; }
    { EpiRes e; e.xin = p.x; e.out = p.out; e.gate = mod + 2048; run_gemm(lds, (const bf16_t*)(p.ws + WS_MIX), (const bf16_t*)(p.ws + WS_WOUT), 1024, 1024, e); }
    GSYNC();
    phase_norm(p.out, p.norm2_g, mod, 3072, 4096, (bf16_t*)(p.ws + WS_H));
    GSYNC();
    { EpiAct e; e.O = (bf16_t*)(p.ws + WS_ACT); run_gemm(lds, (const bf16_t*)(p.ws + WS_H), (const bf16_t*)(p.ws + WS_WGU), 2 * DFF, 1024, e); }
    GSYNC();
    { EpiRes e; e.xin = p.out; e.out = p.out; e.gate = mod + 5120; run_gemm(lds, (const bf16_t*)(p.ws + WS_ACT), (const bf16_t*)(p.ws + WS_WDN), 1024, DFF, e); }
    GSYNC();
    phase_final(p.out, p.final_g);
}

extern "C" void kernel_launch(void* const* d_in, const int* in_sizes, int n_in, void* d_out, int out_size, void* d_ws, size_t ws_size, hipStream_t stream) {
    static int grid_blocks = 0;
    if (!grid_blocks) {
        int dev = 0, cus = 0, per_cu = 0;
        hipGetDevice(&dev);
        hipDeviceGetAttribute(&cus, hipDeviceAttributeMultiprocessorCount, dev);
        hipFuncSetAttribute((const void*)fwd_megakernel, hipFuncAttributeMaxDynamicSharedMemorySize, LDS_BYTES);
        hipOccupancyMaxActiveBlocksPerMultiprocessor(&per_cu, (const void*)fwd_megakernel, 512, LDS_BYTES);
        if (per_cu < 1) { fprintf(stderr, "occupancy query says %d blocks/CU\n", per_cu); per_cu = 1; }
        grid_blocks = cus * 1;
        (void)hipGetLastError();
    }
    Params p{};
    const float** f = (const float**)&p;
    for (int i = 0; i < 24; ++i) f[i] = (const float*)d_in[i];
    p.out = (float*)d_out; p.ws = (unsigned char*)d_ws;
    void* args[] = {&p};
    hipError_t e = hipLaunchCooperativeKernel((const void*)fwd_megakernel, dim3(grid_blocks), dim3(512), args, LDS_BYTES, stream);
    if (e != hipSuccess) fprintf(stderr, "cooperative launch failed: %s (grid %d)\n", hipGetErrorString(e), grid_blocks);
}
```

```cpp
#include <hip/hip_runtime.h>
#include <hip/hip_cooperative_groups.h>
#include <cstdio>
namespace cg = cooperative_groups;
namespace pg8 {
#define PG8_LAS __attribute__((address_space(3)))
typedef unsigned short bf16_t;
typedef short bf16x8 __attribute__((ext_vector_type(8)));
typedef float f32x4 __attribute__((ext_vector_type(4)));
typedef unsigned u32x4 __attribute__((ext_vector_type(4)));
constexpr int BM = 256, BK = 64, HALF = 128, HTB = HALF * BK * 2  , STAGE_BYTES = 8 * HTB, NXCD = 8, WGM = 8;

__host__ __device__ __forceinline__ int lds_byte(int r, int c) { const int st = (r >> 4) * 2 + (c >> 5), rr = r & 15, cc = c & 31, ob = rr * 64 + cc * 2; return st * 1024 + (ob ^ (((ob >> 9) & 1) << 5)); }
__host__ __device__ __forceinline__ void stage_rc(int b, int& R, int& C) { const int st = b / 1024, sb = b % 1024, swz = sb ^ (((sb >> 9) & 1) << 5); R = (st >> 1) * 16 + swz / 64; C = (st & 1) * 32 + (swz % 64) / 2; }
__host__ __device__ __forceinline__ int perm32(int rho) { const int n = rho >> 4, i = rho & 15; return 8 * (i >> 2) + 4 * n + (i & 3); }

struct Unit { int pm, pn; };
struct Gemm { const bf16_t* A; const bf16_t* Bt; int M, N, K; };

struct StaticOrder {
    int nM, nN, nwg, G, c;
    __host__ __device__ void init(int M, int N, int G_, int c_) { nM = M / BM; nN = N / BM; nwg = nM * nN; G = G_; c = c_; }
    __host__ __device__ bool next(int i, Unit& u) const {
        const long L = (long)i * G + c; if (L >= nwg) return false;
        int wgid = (int)L; { const int q = nwg / NXCD, r = nwg % NXCD, xcd = wgid % NXCD, off = wgid / NXCD; wgid = (xcd < r ? xcd * (q + 1) : r * (q + 1) + (xcd - r) * q) + off; }
        const int nig = WGM * nN, gid = wgid / nig, fm = gid * WGM, gsz = (nM - fm) < WGM ? (nM - fm) : WGM;
        u.pm = fm + ((wgid % nig) % gsz); u.pn = (wgid % nig) / gsz; return true;
    }
    __device__ __forceinline__ void a_ready(const Unit&) const {}
    __device__ __forceinline__ void done(const Unit&) const {}
};
typedef float f32x2_t __attribute__((ext_vector_type(2)));
typedef __bf16 bf16x2_t __attribute__((ext_vector_type(2)));
__device__ __forceinline__ unsigned cvt_pk_bf16(float lo, float hi) { const f32x2_t v = {lo, hi}; const bf16x2_t r = __builtin_convertvector(v, bf16x2_t); return __builtin_bit_cast(unsigned, r); }

template <class Epi, class Sched, bool STAMP = false>
__device__ __forceinline__ void gemm_phase(PG8_LAS unsigned char* lds, const Gemm g, const Sched& S, const Epi& E, unsigned long long* stamps) {
    const int tid = threadIdx.x, wid = __builtin_amdgcn_readfirstlane(tid >> 6), lane = tid & 63, wr = wid >> 2, wc = wid & 3, fr = lane & 15, fq = lane >> 4;
    const int K = g.K, nt = K / BK;
    int ts_lo = 0, ts_hi = 0, nts = 0; const unsigned long long rt_entry = STAMP ? (unsigned long long)wall_clock64() : 0ull;
#define PG8_STAMP() do { if (STAMP && wid == 0 && nts < 64) { const unsigned long long _c = (unsigned long long)clock64(); \
        ts_lo = (lane == nts) ? (int)(unsigned)_c : ts_lo; ts_hi = (lane == nts) ? (int)(unsigned)(_c >> 32) : ts_hi; ++nts; } } while (0)
    PG8_STAMP();
    unsigned voffA[2], voffB[2];
#pragma unroll
    for (int i = 0; i < 2; ++i) { int R, C; stage_rc(tid * 16 + i * 8192, R, C); const int Rb = Epi::PERM ? ((R & ~31) + perm32(R & 31)) : R;
        voffA[i] = (unsigned)(R * K + C) * 2u; voffB[i] = (unsigned)(Rb * K + C) * 2u; }
    const size_t kstep = (size_t)(BK * 2);
    const size_t hstep = (size_t)HALF * K * 2;
    const size_t tstep = 2 * hstep;
    const unsigned ldsw = (unsigned)wid * 1024u;
    const int aoff = lds_byte(wr * 64 + fr, fq * 8), boff = lds_byte(wc * 32 + fr, fq * 8);
#define PG8_SA(b, h) (((b) * 2 + (h)) * HTB)
#define PG8_SB(b, h) ((4 + (b) * 2 + (h)) * HTB)
#define PG8_STAGE(bufoff, gbase, voff) do { _Pragma("unroll") for (int _i = 0; _i < 2; ++_i) \
        __builtin_amdgcn_global_load_lds((const unsigned*)((const char*)(gbase) + (voff)[_i]), (PG8_LAS unsigned*)(lds + (bufoff) + ldsw + _i * 8192), 16, 0, 0); } while (0)
#define PG8_LDA(dst, b, h) do { _Pragma("unroll") for (int m = 0; m < 4; ++m) _Pragma("unroll") for (int k = 0; k < 2; ++k) dst[m][k] = *(const PG8_LAS bf16x8*)(lds + PG8_SA(b, h) + aoff + m * 2048 + k * 1024); } while (0)
#define PG8_LDB(dst, b, h) do { _Pragma("unroll") for (int n = 0; n < 2; ++n) _Pragma("unroll") for (int k = 0; k < 2; ++k) dst[n][k] = *(const PG8_LAS bf16x8*)(lds + PG8_SB(b, h) + boff + n * 2048 + k * 1024); } while (0)
#define PG8_MMA(ai, bj, At, Bt) do { __builtin_amdgcn_s_setprio(1); _Pragma("unroll") for (int m = 0; m < 4; ++m) _Pragma("unroll") for (int n = 0; n < 2; ++n) _Pragma("unroll") for (int k = 0; k < 2; ++k) \
        acc[ai][bj][m][n] = __builtin_amdgcn_mfma_f32_16x16x32_bf16(Bt[n][k], At[m][k], acc[ai][bj][m][n], 0, 0, 0); __builtin_amdgcn_s_setprio(0); } while (0)
#define PG8_WAIT_V(n) asm volatile("s_waitcnt vmcnt(" #n ")" ::: "memory")
#define PG8_WAIT_L(n) asm volatile("s_waitcnt lgkmcnt(" #n ")" ::: "memory")
#define PG8_BAR __builtin_amdgcn_s_barrier()
#define PG8_SCHED __builtin_amdgcn_sched_barrier(0)
    Unit cur, nxt; int ui = 0;
    if (!S.next(0, cur)) return;
    f32x4 acc[2][2][4][2];
#pragma unroll
    for (int a = 0; a < 2; ++a)
#pragma unroll
        for (int b = 0; b < 2; ++b)
#pragma unroll
            for (int m = 0; m < 4; ++m)
#pragma unroll
                for (int n = 0; n < 2; ++n) acc[a][b][m][n] = (f32x4){0.f, 0.f, 0.f, 0.f};
    bf16x8 At[4][2], B0[2][2], B1[2][2];
    const char* cA = (const char*)g.A + (size_t)cur.pm * tstep; const char* cB = (const char*)g.Bt + (size_t)cur.pn * tstep;
    S.a_ready(cur);
    PG8_STAGE(PG8_SB(0, 0), cB, voffB); PG8_STAGE(PG8_SA(0, 0), cA, voffA); PG8_STAGE(PG8_SB(0, 1), cB + hstep, voffB); PG8_STAGE(PG8_SA(0, 1), cA + hstep, voffA);
    if (wr == 1) PG8_BAR;
    PG8_WAIT_V(4); PG8_BAR;
    PG8_STAGE(PG8_SB(1, 0), cB + kstep, voffB); PG8_STAGE(PG8_SA(1, 0), cA + kstep, voffA); PG8_STAGE(PG8_SB(1, 1), cB + hstep + kstep, voffB);
    PG8_WAIT_V(6); PG8_BAR;
    PG8_STAMP();
    for (;;) {
        const bool has_next = S.next(ui + 1, nxt);
        const char* nA = has_next ? (const char*)g.A + (size_t)nxt.pm * tstep : cA; const char* nB = has_next ? (const char*)g.Bt + (size_t)nxt.pn * tstep : cB;
        for (int t = 0; t < nt; t += 2) {
            const bool last = (t == nt - 2);
            const char* a1 = cA + (size_t)(t + 1) * kstep;
            const char* a2 = last ? nA : cA + (size_t)(t + 2) * kstep; const char* b2 = last ? nB : cB + (size_t)(t + 2) * kstep;
            const char* a3 = a2 + kstep; const char* b3 = b2 + kstep;
            if (last && has_next) S.a_ready(nxt);
            PG8_LDB(B0, 0, 0); PG8_SCHED; PG8_LDA(At, 0, 0); PG8_STAGE(PG8_SA(1, 1), a1 + hstep, voffA);
            PG8_WAIT_L(8); PG8_BAR; PG8_WAIT_L(0); PG8_MMA(0, 0, At, B0); PG8_BAR; PG8_SCHED;
            PG8_LDB(B1, 0, 1); PG8_STAGE(PG8_SB(0, 0), b2, voffB);
            PG8_BAR; PG8_WAIT_L(0); PG8_MMA(0, 1, At, B1); PG8_BAR;
            PG8_LDA(At, 0, 1); PG8_STAGE(PG8_SA(0, 0), a2, voffA);
            PG8_BAR; PG8_WAIT_L(0); PG8_MMA(1, 0, At, B0); PG8_BAR; PG8_SCHED;
            PG8_STAGE(PG8_SB(0, 1), b2 + hstep, voffB);
            PG8_WAIT_V(6); PG8_BAR; PG8_MMA(1, 1, At, B1); PG8_BAR;
            PG8_LDB(B0, 1, 0); PG8_SCHED; PG8_LDA(At, 1, 0); PG8_STAGE(PG8_SA(0, 1), a2 + hstep, voffA);
            PG8_WAIT_L(8); PG8_BAR; PG8_WAIT_L(0); PG8_MMA(0, 0, At, B0); PG8_BAR; PG8_SCHED;
            PG8_LDB(B1, 1, 1); PG8_STAGE(PG8_SB(1, 0), b3, voffB);
            PG8_BAR; PG8_WAIT_L(0); PG8_MMA(0, 1, At, B1); PG8_BAR;
            PG8_LDA(At, 1, 1); PG8_STAGE(PG8_SA(1, 0), a3, voffA);
            PG8_BAR; PG8_WAIT_L(0); PG8_MMA(1, 0, At, B0); PG8_BAR; PG8_SCHED;
            PG8_STAGE(PG8_SB(1, 1), b3 + hstep, voffB);
            PG8_WAIT_V(6); PG8_BAR; PG8_MMA(1, 1, At, B1); PG8_BAR;
        }
        PG8_STAMP();
        if constexpr (!Epi::AFTER_DRAIN) { E(acc, cur, wr, wc, fr, fq); S.done(cur); }
        PG8_STAMP();
        if (!has_next) break;
#pragma unroll
        for (int a = 0; a < 2; ++a)
#pragma unroll
            for (int b = 0; b < 2; ++b)
#pragma unroll
                for (int m = 0; m < 4; ++m)
#pragma unroll
                    for (int n = 0; n < 2; ++n) acc[a][b][m][n] = (f32x4){0.f, 0.f, 0.f, 0.f};
        cur = nxt; cA = nA; cB = nB; ++ui;
    }
    PG8_WAIT_V(0);
    if (wr == 0) PG8_BAR;
    PG8_BAR;
    if constexpr (Epi::AFTER_DRAIN) { E.fused(acc, cur, wr, wc, fr, fq, lds, wid, lane); S.done(cur); }
    PG8_STAMP();
    if (STAMP && wid == 0) { stamps[lane] = lane < nts ? (((unsigned long long)(unsigned)ts_hi << 32) | (unsigned)ts_lo) : 0ull;
        if (lane == 62) stamps[62] = rt_entry; if (lane == 63) stamps[63] = (unsigned long long)wall_clock64(); }
#undef PG8_STAMP
#undef PG8_SA
#undef PG8_SB
#undef PG8_STAGE
#undef PG8_LDA
#undef PG8_LDB
#undef PG8_MMA
#undef PG8_WAIT_V
#undef PG8_WAIT_L
#undef PG8_BAR
#undef PG8_SCHED
}
}

using pg8::bf16_t; using pg8::bf16x8; using pg8::f32x4; using pg8::u32x4; using pg8::cvt_pk_bf16;
#define LAS __attribute__((address_space(3)))
typedef unsigned u32x2 __attribute__((ext_vector_type(2)));

constexpr int MTOK = 16384, DM = 1024, INC = 2304, DFF = 2816, SEQ = 8192;
constexpr size_t MiB = 1ull << 20;
constexpr size_t WS_WIN = 0, WS_WOUT = 4718592, WS_WGU = 6815744, WS_WDN = 18350080, WS_WPOOL = 24117248, WS_WDEC = 24248320,
                 WS_WICLR = 24313856, WS_WGATE = 24379392, WS_MOD = 24510464, WS_GAM = 24559616,
                 WS_H = 24 * MiB, WS_MP = 24 * MiB, WS_P = 40 * MiB, WS_Z = 56 * MiB, WS_ACT = 56 * MiB, WS_GATE = 128 * MiB,
                 WS_BONUS = 144 * MiB, WS_HST = 160 * MiB, WS_MIX = 176 * MiB;
constexpr int LDS_ST = 143360;
constexpr int LDS_BYTES = 143376;
constexpr size_t WS_BAR = 208 * MiB;
constexpr int TS = 144;
constexpr int R_AT = 0, R_BT = 9216, R_KT = 18432, R_RT = 27648, R_VT = 36864, R_BH = 46080, R_KH = 55296, R_AAK = 64512, R_ARB = 73728, R_ARK = 82944,
              R_AAB = 92160, R_RHS = 108544;
constexpr int R_TX = R_AT, R_XA = R_BT, R_SG = R_KT  , R_WT = R_AT, R_UT = R_BT;
constexpr int R_DL = R_AAK  , R_SEG = R_ARK, R_AL = R_RHS, R_GG = R_RHS + 17408;
constexpr int FS = 272;
constexpr int RS = 544;

struct Params {
    const float *x, *c, *ada_w, *ada_b, *norm1_g, *w_in, *mu_shift, *pool_w, *pool_scale, *w0, *w_decay_up, *a0, *w_iclr_up, *w_gate_up,
                *k_k, *k_a, *r_k, *lnx_w, *lnx_b, *w_out, *norm2_g, *w_ffn_gu, *w_ffn_down, *final_g;
    float* out; unsigned char* ws;
};

__device__ __forceinline__ float bf2f(unsigned v) { return __uint_as_float(v << 16); }
__device__ __forceinline__ float wave_sum(float v) {
#pragma unroll
    for (int o = 32; o > 0; o >>= 1) v += __shfl_xor(v, o);
    return v;
}
__device__ __forceinline__ float quad_sum(float v) {
    int t = __builtin_amdgcn_update_dpp(0, __float_as_int(v), 0xB1, 0xF, 0xF, true); v += __int_as_float(t);
    t = __builtin_amdgcn_update_dpp(0, __float_as_int(v), 0x4E, 0xF, 0xF, true); v += __int_as_float(t);
    return v;
}
__device__ __forceinline__ void unpack8(u32x4 v, float (&f)[8]) {
#pragma unroll
    for (int i = 0; i < 4; ++i) { f[2 * i] = __uint_as_float(v[i] << 16); f[2 * i + 1] = __uint_as_float(v[i] & 0xffff0000u); }
}
__device__ __forceinline__ u32x4 pack8(const float (&f)[8]) { return (u32x4){cvt_pk_bf16(f[0], f[1]), cvt_pk_bf16(f[2], f[3]), cvt_pk_bf16(f[4], f[5]), cvt_pk_bf16(f[6], f[7])}; }
__device__ __forceinline__ unsigned short f2bf(float f) { return (unsigned short)(cvt_pk_bf16(f, 0.f) & 0xffffu); }

__device__ __forceinline__ f32x4 mm_lds(const LAS unsigned char* A, int sa, int m0, const LAS unsigned char* Bt, int sb, int n0, int K, int lane, f32x4 acc) {
    const LAS unsigned char* ap = A + (m0 + (lane & 15)) * sa + (lane >> 4) * 16;
    const LAS unsigned char* bp = Bt + (n0 + (lane & 15)) * sb + (lane >> 4) * 16;
#pragma unroll
    for (int k0 = 0; k0 < K; k0 += 32) {
        const bf16x8 a = *(const LAS bf16x8*)(ap + k0 * 2), b = *(const LAS bf16x8*)(bp + k0 * 2);
        acc = __builtin_amdgcn_mfma_f32_16x16x32_bf16(b, a, acc, 0, 0, 0);
    }
    return acc;
}
__device__ __forceinline__ f32x4 mm_lds_g(const LAS unsigned char* A, int sa, int m0, const unsigned char* Bt, int sb, int n0, int K, int lane, f32x4 acc) {
    const LAS unsigned char* ap = A + (m0 + (lane & 15)) * sa + (lane >> 4) * 16;
    const unsigned char* bp = Bt + (size_t)(n0 + (lane & 15)) * sb + (lane >> 4) * 16;
#pragma unroll
    for (int k0 = 0; k0 < K; k0 += 32) {
        const bf16x8 a = *(const LAS bf16x8*)(ap + k0 * 2), b = *(const bf16x8*)(bp + k0 * 2);
        acc = __builtin_amdgcn_mfma_f32_16x16x32_bf16(b, a, acc, 0, 0, 0);
    }
    return acc;
}

#define XB_TMO      128
#define XB_XCNT(j)  (256  + 64 * (j))
#define XB_XSUB(j)  (1280 + 64 * (j))
#define XB_XGEN(j)  (2304 + 64 * (j))
#define XB_TOP      3328
#define XB_TOPGEN   3392
#define XCD_BAR_WORDS 3456
#define XB_SPIN_CAP (1u << 18)

__device__ __forceinline__ unsigned xb_ld(unsigned* p)              { return __hip_atomic_load(p, __ATOMIC_RELAXED, __HIP_MEMORY_SCOPE_AGENT); }
__device__ __forceinline__ unsigned xb_add(unsigned* p, unsigned v) { return __hip_atomic_fetch_add(p, v, __ATOMIC_RELAXED, __HIP_MEMORY_SCOPE_AGENT); }
__device__ __forceinline__ unsigned xb_xcc_id() { return (unsigned)__builtin_amdgcn_s_getreg((3 << 11) | 20) & 0xFu; }
#define XB_SPIN(cond, bar) do { unsigned _sp = 0; while (cond) { __builtin_amdgcn_s_sleep(1); \
    if ((++_sp & 255u) == 0u) { if (xb_ld(&(bar)[XB_TMO])) break; if (_sp > XB_SPIN_CAP) { atomicAdd(&(bar)[XB_TMO], 1u); break; } } } } while (0)

struct XcdBarrier {
    unsigned* bar; unsigned x;
    volatile LAS unsigned* st;
};

__device__ __forceinline__ XcdBarrier xcd_barrier_post(unsigned* bar, volatile LAS unsigned* st) {
    XcdBarrier b; b.bar = bar; b.x = xb_xcc_id(); b.st = st;
    if (threadIdx.x == 0) (void)xb_add(&bar[XB_XCNT(b.x)], 1u);
    return b;
}
__device__ __forceinline__ void xcd_barrier_complete(unsigned* bar, unsigned x, unsigned& nloc, unsigned& nx) {
    const unsigned G = gridDim.x * gridDim.y * gridDim.z;
    unsigned sum, cnt, mine, sp = 0u;
    for (;;) {
        sum = 0u; cnt = 0u; mine = 0u;
#pragma unroll
        for (unsigned j = 0; j < 16; ++j) { const unsigned c = xb_ld(&bar[XB_XCNT(j)]); sum += c; cnt += (c > 0u) ? 1u : 0u; mine = (j == x) ? c : mine; }
        if (sum == G) break;
        __builtin_amdgcn_s_sleep(1);
        if ((++sp & 255u) == 0u) { if (xb_ld(&bar[XB_TMO])) break; if (sp > XB_SPIN_CAP) { atomicAdd(&bar[XB_TMO], 1u); break; } }
    }
    nloc = mine > 0u ? mine : 1u; nx = cnt > 0u ? cnt : 1u;
}

__device__ __forceinline__ void xcd_barrier(const XcdBarrier& b) {
    asm volatile("s_waitcnt vmcnt(0)" ::: "memory");
    __syncthreads();
    if (threadIdx.x == 0) {
        unsigned* bar = b.bar;
        __builtin_amdgcn_s_waitcnt(0);
        unsigned nloc = b.st[0], nx = b.st[1];
        if (nloc == 0u) { xcd_barrier_complete(bar, b.x, nloc, nx); b.st[0] = nloc; b.st[1] = nx; }
        const unsigned old = xb_add(&bar[XB_XSUB(b.x)], 1u);
        const unsigned gen = old / nloc;
        if (old + 1u == (gen + 1u) * nloc) {
            __builtin_amdgcn_fence(__ATOMIC_RELEASE, "agent");
            asm volatile("s_waitcnt vmcnt(0)" ::: "memory");
            const unsigned og = xb_add(&bar[XB_TOP], 1u);
            const unsigned tg = og / nx;
            if (og + 1u == (tg + 1u) * nx) xb_add(&bar[XB_TOPGEN], 1u);
            else XB_SPIN(xb_ld(&bar[XB_TOPGEN]) == tg, bar);
            __builtin_amdgcn_fence(__ATOMIC_ACQUIRE, "agent");
            xb_add(&bar[XB_XGEN(b.x)], 1u);
            asm volatile("s_waitcnt vmcnt(0)" ::: "memory");
        } else {
            XB_SPIN(xb_ld(&bar[XB_XGEN(b.x)]) == gen, bar);
            __builtin_amdgcn_fence(__ATOMIC_ACQUIRE, "agent");
            asm volatile("s_waitcnt vmcnt(0)" ::: "memory");
        }
    }
    __syncthreads();
}

__device__ __forceinline__ void conv_tile(LAS float* tile, const float* W, bf16_t* Wt, int K, int N, int kt, int nt, int mode) {
    const int tid = threadIdx.x, k0 = kt * 64, n0 = nt * 64;
    const int r = tid >> 4, c4 = (tid & 15) * 4;
#pragma unroll
    for (int i = 0; i < 2; ++i) { const int rr = r + 32 * i; const float4 v = *(const float4*)(W + (size_t)(k0 + rr) * N + n0 + c4);
        tile[rr * 65 + c4 + 0] = v.x; tile[rr * 65 + c4 + 1] = v.y; tile[rr * 65 + c4 + 2] = v.z; tile[rr * 65 + c4 + 3] = v.w; }
    __syncthreads();
    const int n = tid >> 3, k8 = (tid & 7) * 8;
    float f[8];
#pragma unroll
    for (int j = 0; j < 8; ++j) f[j] = tile[(k8 + j) * 65 + n];
    const int col = n0 + n; int drow = col;
    if (mode == 1) drow = col < DFF ? (col / 128) * 256 + (col % 128) : ((col - DFF) / 128) * 256 + 128 + ((col - DFF) % 128);
    *(u32x4*)(Wt + (size_t)drow * K + k0 + k8) = pack8(f);
    __syncthreads();
}
__device__ __forceinline__ void mod_unit(LAS float* red, const Params& p, int u) {
    const int tid = threadIdx.x, w = tid >> 6, lane = tid & 63, n = u * 64 + lane;
    float a0 = 0.f, a1 = 0.f;
#pragma unroll 8
    for (int k = w * 128; k < w * 128 + 128; ++k) {
        const float wv = p.ada_w[(size_t)k * 6144 + n]; const float c0 = p.c[k], c1 = p.c[1024 + k];
        a0 += (c0 / (1.f + __expf(-c0))) * wv; a1 += (c1 / (1.f + __expf(-c1))) * wv;
    }
    red[(w * 2 + 0) * 64 + lane] = a0; red[(w * 2 + 1) * 64 + lane] = a1;
    __syncthreads();
    if (tid < 128) { const int b = tid >> 6; float s = 0.f;
#pragma unroll
        for (int w2 = 0; w2 < 8; ++w2) s += red[(w2 * 2 + b) * 64 + lane];
        ((float*)(p.ws + WS_MOD))[b * 6144 + n] = s + p.ada_b[n]; }
    __syncthreads();
}
__device__ void phase0(LAS unsigned char* lds, const Params& p) {
    if (blockIdx.x < 96) mod_unit((LAS float*)lds, p, blockIdx.x);
    for (int t = (int)blockIdx.x; t < 2992; t += (int)gridDim.x) {
        const float* src; bf16_t* dst; int K, N, mode = 0, loc;
        if (t < 576) { loc = t; src = p.w_in; dst = (bf16_t*)(p.ws + WS_WIN); K = 1024; N = INC; }
        else if (t < 832) { loc = t - 576; src = p.w_out; dst = (bf16_t*)(p.ws + WS_WOUT); K = 1024; N = 1024; }
        else if (t < 2240) { loc = t - 832; src = p.w_ffn_gu; dst = (bf16_t*)(p.ws + WS_WGU); K = 1024; N = 2 * DFF; mode = 1; }
        else if (t < 2944) { loc = t - 2240; src = p.w_ffn_down; dst = (bf16_t*)(p.ws + WS_WDN); K = DFF; N = 1024; }
        else if (t < 2960) { const int g = (t - 2944) >> 2; loc = (t - 2944) & 3; src = p.pool_w + g * 16384; dst = (bf16_t*)(p.ws + WS_WPOOL) + g * 16384; K = 128; N = 128; }
        else if (t < 2968) { loc = t - 2960; src = p.w_decay_up; dst = (bf16_t*)(p.ws + WS_WDEC); K = 64; N = 512; }
        else if (t < 2976) { loc = t - 2968; src = p.w_iclr_up; dst = (bf16_t*)(p.ws + WS_WICLR); K = 64; N = 512; }
        else { loc = t - 2976; src = p.w_gate_up; dst = (bf16_t*)(p.ws + WS_WGATE); K = 128; N = 512; }
        const int ntn = N / 64;
        conv_tile((LAS float*)lds, src, dst, K, N, loc / ntn, loc % ntn, mode);
    }
}

__device__ void phase_norm(const float* X, const float* g, const float* mod, int sh_off, int sc_off, bf16_t* H) {
    const int wid = threadIdx.x >> 6, lane = threadIdx.x & 63;
    for (int row = (int)blockIdx.x * 8 + wid; row < MTOK; row += (int)gridDim.x * 8) {
        const int b = row >> 13; const float* xr = X + (size_t)row * DM; const float* mb = mod + b * 6144;
        float4 v[4]; float ss = 0.f;
#pragma unroll
        for (int j = 0; j < 4; ++j) { v[j] = *(const float4*)(xr + (j * 64 + lane) * 4); ss += v[j].x * v[j].x + v[j].y * v[j].y + v[j].z * v[j].z + v[j].w * v[j].w; }
        ss = wave_sum(ss); const float rstd = rsqrtf(ss * (1.f / 1024.f) + 1e-6f);
#pragma unroll
        for (int j = 0; j < 4; ++j) { const int col = (j * 64 + lane) * 4;
            const float4 gg = *(const float4*)(g + col), sc = *(const float4*)(mb + sc_off + col), sh = *(const float4*)(mb + sh_off + col);
            const float h0 = (v[j].x * rstd * gg.x) * (1.f + sc.x) + sh.x, h1 = (v[j].y * rstd * gg.y) * (1.f + sc.y) + sh.y,
                        h2 = (v[j].z * rstd * gg.z) * (1.f + sc.z) + sh.z, h3 = (v[j].w * rstd * gg.w) * (1.f + sc.w) + sh.w;
            *(u32x2*)(H + (size_t)row * DM + col) = (u32x2){cvt_pk_bf16(h0, h1), cvt_pk_bf16(h2, h3)}; }
    }
}
__device__ void phase_final(float* X, const float* g) {
    const int wid = threadIdx.x >> 6, lane = threadIdx.x & 63;
    for (int row = (int)blockIdx.x * 8 + wid; row < MTOK; row += (int)gridDim.x * 8) {
        float* xr = X + (size_t)row * DM;
        float4 v[4]; float ss = 0.f;
#pragma unroll
        for (int j = 0; j < 4; ++j) { v[j] = *(const float4*)(xr + (j * 64 + lane) * 4); ss += v[j].x * v[j].x + v[j].y * v[j].y + v[j].z * v[j].z + v[j].w * v[j].w; }
        ss = wave_sum(ss); const float rstd = rsqrtf(ss * (1.f / 1024.f) + 1e-6f);
#pragma unroll
        for (int j = 0; j < 4; ++j) { const int col = (j * 64 + lane) * 4; const float4 gg = *(const float4*)(g + col);
            *(float4*)(xr + col) = make_float4(v[j].x * rstd * gg.x, v[j].y * rstd * gg.y, v[j].z * rstd * gg.z, v[j].w * rstd * gg.w); }
    }
}

struct EpiZ {
    static constexpr bool PERM = true, AFTER_DRAIN = false;
    bf16_t* O; int ldc;
    __device__ __forceinline__ void operator()(const f32x4 (&acc)[2][2][4][2], const pg8::Unit& u, int wr, int wc, int fr, int fq) const {
        const int row0 = u.pm * 256 + wr * 64 + fr, col0 = u.pn * 256 + wc * 32 + 8 * fq;
#pragma unroll
        for (int ai = 0; ai < 2; ++ai)
#pragma unroll
            for (int m = 0; m < 4; ++m) { bf16_t* rowp = O + (size_t)(row0 + ai * 128 + m * 16) * ldc + col0;
#pragma unroll
                for (int bj = 0; bj < 2; ++bj) { const f32x4 v0 = acc[ai][bj][m][0], v1 = acc[ai][bj][m][1];
                    *(u32x4*)(rowp + bj * 128) = (u32x4){cvt_pk_bf16(v0[0], v0[1]), cvt_pk_bf16(v0[2], v0[3]), cvt_pk_bf16(v1[0], v1[1]), cvt_pk_bf16(v1[2], v1[3])}; } }
    }
};
struct EpiRes {
    static constexpr bool PERM = false, AFTER_DRAIN = false;
    const float* xin; float* out; const float* gate;
    __device__ __forceinline__ void operator()(const f32x4 (&acc)[2][2][4][2], const pg8::Unit& u, int wr, int wc, int fr, int fq) const {
        const int row0 = u.pm * 256 + wr * 64 + fr, col0 = u.pn * 256 + wc * 32 + 4 * fq;
        const float* gb = gate + (u.pm >> 5) * 6144;
        f32x4 gv[2][2];
#pragma unroll
        for (int bj = 0; bj < 2; ++bj)
#pragma unroll
            for (int n = 0; n < 2; ++n) gv[bj][n] = *(const f32x4*)(gb + col0 + bj * 128 + n * 16);
#pragma unroll
        for (int ai = 0; ai < 2; ++ai)
#pragma unroll
            for (int m = 0; m < 4; ++m) { const size_t ro = (size_t)(row0 + ai * 128 + m * 16) * DM + col0;
#pragma unroll
                for (int bj = 0; bj < 2; ++bj)
#pragma unroll
                    for (int n = 0; n < 2; ++n) { const f32x4 xv = *(const f32x4*)(xin + ro + bj * 128 + n * 16);
                        *(f32x4*)(out + ro + bj * 128 + n * 16) = xv + gv[bj][n] * acc[ai][bj][m][n]; } }
    }
};
struct EpiAct {
    static constexpr bool PERM = true, AFTER_DRAIN = false;
    bf16_t* O;
    __device__ __forceinline__ void operator()(const f32x4 (&acc)[2][2][4][2], const pg8::Unit& u, int wr, int wc, int fr, int fq) const {
        const int row0 = u.pm * 256 + wr * 64 + fr, col0 = u.pn * 128 + wc * 32 + 8 * fq;
#pragma unroll
        for (int ai = 0; ai < 2; ++ai)
#pragma unroll
            for (int m = 0; m < 4; ++m) { float r[8];
#pragma unroll
                for (int n = 0; n < 2; ++n)
#pragma unroll
                    for (int e = 0; e < 4; ++e) { const float gt = acc[ai][0][m][n][e], up = acc[ai][1][m][n][e]; r[n * 4 + e] = gt / (1.f + __expf(-gt)) * up; }
                *(u32x4*)(O + (size_t)(row0 + ai * 128 + m * 16) * DFF + col0) = pack8(r); }
    }
};
template <class Epi> __device__ __forceinline__ void run_gemm(LAS unsigned char* lds, const bf16_t* A, const bf16_t* Bt, int N, int K, const Epi& E) {
    pg8::Gemm g; g.A = A; g.Bt = Bt; g.M = MTOK; g.N = N; g.K = K;
    pg8::StaticOrder S; S.init(MTOK, N, (int)gridDim.x, (int)blockIdx.x);
    pg8::gemm_phase<Epi, pg8::StaticOrder, false>(lds, g, S, E, nullptr);
}

__device__ void pool_item(LAS unsigned char* lds, const Params& p, int tt, int g) {
    const int tid = threadIdx.x, t = tid >> 3, cgp = tid & 7, wid = tid >> 6, lane = tid & 63;
    const bf16_t* Z = (const bf16_t*)(p.ws + WS_Z);
    const int row = tt * 64 + t, tl = row & (SEQ - 1), w = 2 << g, cnt = (tl + 1) < w ? (tl + 1) : w;
    const bf16_t* zp = Z + (size_t)row * INC + g * 128 + cgp * 16;
    float s[16], u0[16];
    { float a[8], b[8]; unpack8(*(const u32x4*)zp, a); unpack8(*(const u32x4*)(zp + 8), b);
#pragma unroll
      for (int e = 0; e < 8; ++e) { u0[e] = a[e]; u0[8 + e] = b[e]; s[e] = a[e]; s[8 + e] = b[e]; } }
    for (int q = 1; q < cnt; ++q) { float a[8], b[8]; unpack8(*(const u32x4*)(zp - (size_t)q * INC), a); unpack8(*(const u32x4*)(zp - (size_t)q * INC + 8), b);
#pragma unroll
        for (int e = 0; e < 8; ++e) { s[e] += a[e]; s[8 + e] += b[e]; } }
    const float inv = 1.f / (float)cnt;
    float d0[8], d1[8];
#pragma unroll
    for (int e = 0; e < 8; ++e) { d0[e] = s[e] * inv - u0[e]; d1[e] = s[8 + e] * inv - u0[8 + e]; }
    *(LAS u32x4*)(lds + t * 272 + cgp * 32) = pack8(d0); *(LAS u32x4*)(lds + t * 272 + cgp * 32 + 16) = pack8(d1);
    __syncthreads();
    const unsigned char* Bt = p.ws + WS_WPOOL + (size_t)g * 32768;
    const float4 ps = *(const float4*)(p.pool_scale + g * 128 + wid * 16 + 4 * (lane >> 4));
    bf16_t* mix = (bf16_t*)(p.ws + WS_MIX);
#pragma unroll
    for (int m = 0; m < 4; ++m) {
        f32x4 acc = {0.f, 0.f, 0.f, 0.f};
        acc = mm_lds_g(lds, 272, m * 16, Bt, 256, wid * 16, 128, lane, acc);
        const int orow = tt * 64 + m * 16 + (lane & 15), ocol = g * 128 + wid * 16 + 4 * (lane >> 4);
        *(u32x2*)(mix + (size_t)orow * DM + ocol) = (u32x2){cvt_pk_bf16(acc[0] * ps.x, acc[1] * ps.y), cvt_pk_bf16(acc[2] * ps.z, acc[3] * ps.w)};
    }
    __syncthreads();
}

__device__ __forceinline__ void shifted8(const bf16_t* Z, int row, bool has_prev, int col, const float* mu_shift, float (&o)[8]) {
    float cur[8], prv[8];
    unpack8(*(const u32x4*)(Z + (size_t)row * INC + col), cur);
    if (has_prev) unpack8(*(const u32x4*)(Z + (size_t)(row - 1) * INC + col), prv);
    else {
#pragma unroll
        for (int e = 0; e < 8; ++e) prv[e] = 0.f; }
    const float4 m0 = *(const float4*)(mu_shift + col - 512), m1 = *(const float4*)(mu_shift + col - 512 + 4);
    const float mu[8] = {m0.x, m0.y, m0.z, m0.w, m1.x, m1.y, m1.z, m1.w};
#pragma unroll
    for (int e = 0; e < 8; ++e) o[e] = cur[e] + (prv[e] - cur[e]) * mu[e];
}
__device__ void scan_pre_item(LAS unsigned char* lds, const Params& p, int item) {
    const int tid = threadIdx.x, t = tid >> 3, jg = tid & 7, wid = tid >> 6, lane = tid & 63;
    const int h = item & 7, c = (item >> 3) & 127, b = item >> 10;
    const bf16_t* Z = (const bf16_t*)(p.ws + WS_Z);
    const int row = b * SEQ + c * 64 + t; const bool has_prev = (c * 64 + t) > 0;
    const int hc = h * 64 + jg * 8;
    float r8[8], k8[8], v8[8];
    shifted8(Z, row, has_prev, 512 + hc, p.mu_shift, r8);
    shifted8(Z, row, has_prev, 1024 + hc, p.mu_shift, k8);
    shifted8(Z, row, has_prev, 1536 + hc, p.mu_shift, v8);
    { float f[8];
      shifted8(Z, row, has_prev, 2048 + jg * 8, p.mu_shift, f);
#pragma unroll
      for (int e = 0; e < 8; ++e) f[e] = tanhf(f[e]);
      *(LAS u32x4*)(lds + R_TX + t * TS + jg * 16) = pack8(f);
      shifted8(Z, row, has_prev, 2112 + jg * 8, p.mu_shift, f);
      *(LAS u32x4*)(lds + R_XA + t * TS + jg * 16) = pack8(f);
#pragma unroll
      for (int hh = 0; hh < 2; ++hh) { shifted8(Z, row, has_prev, 2176 + jg * 16 + hh * 8, p.mu_shift, f);
#pragma unroll
          for (int e = 0; e < 8; ++e) f[e] = 1.f / (1.f + __expf(-f[e]));
          *(LAS u32x4*)(lds + R_SG + t * 272 + jg * 32 + hh * 16) = pack8(f); } }
    __syncthreads();
    { const int m = wid >> 1;
#pragma unroll
      for (int nn = 0; nn < 2; ++nn) { const int n = (wid & 1) * 2 + nn;
          f32x4 a0 = {0.f, 0.f, 0.f, 0.f}, a1 = a0, a2 = a0;
          a0 = mm_lds_g(lds + R_TX, TS, m * 16, p.ws + WS_WDEC + (size_t)h * 64 * 128, 128, n * 16, 64, lane, a0);
          a1 = mm_lds_g(lds + R_XA, TS, m * 16, p.ws + WS_WICLR + (size_t)h * 64 * 128, 128, n * 16, 64, lane, a1);
          a2 = mm_lds_g(lds + R_SG, 272, m * 16, p.ws + WS_WGATE + (size_t)h * 64 * 256, 256, n * 16, 128, lane, a2);
          const int off = (m * 16 + (lane & 15)) * FS + (n * 16 + 4 * (lane >> 4)) * 4;
          *(LAS f32x4*)(lds + R_DL + off) = a0; *(LAS f32x4*)(lds + R_AL + off) = a1; *(LAS f32x4*)(lds + R_GG + off) = a2; } }
    __syncthreads();
    float av8[8], bv8[8];
    { float dl[8], al[8], gg[8];
      { const f32x4 x0 = *(const LAS f32x4*)(lds + R_DL + t * FS + jg * 32), x1 = *(const LAS f32x4*)(lds + R_DL + t * FS + jg * 32 + 16);
        const f32x4 y0 = *(const LAS f32x4*)(lds + R_AL + t * FS + jg * 32), y1 = *(const LAS f32x4*)(lds + R_AL + t * FS + jg * 32 + 16);
        const f32x4 z0 = *(const LAS f32x4*)(lds + R_GG + t * FS + jg * 32), z1 = *(const LAS f32x4*)(lds + R_GG + t * FS + jg * 32 + 16);
#pragma unroll
        for (int e = 0; e < 4; ++e) { dl[e] = x0[e]; dl[4 + e] = x1[e]; al[e] = y0[e]; al[4 + e] = y1[e]; gg[e] = z0[e]; gg[4 + e] = z1[e]; } }
      float w0v[8], a0v[8], kkv[8], kav[8], rkv[8];
      { const float4 q0 = *(const float4*)(p.w0 + hc), q1 = *(const float4*)(p.w0 + hc + 4); w0v[0] = q0.x; w0v[1] = q0.y; w0v[2] = q0.z; w0v[3] = q0.w; w0v[4] = q1.x; w0v[5] = q1.y; w0v[6] = q1.z; w0v[7] = q1.w; }
      { const float4 q0 = *(const float4*)(p.a0 + hc), q1 = *(const float4*)(p.a0 + hc + 4); a0v[0] = q0.x; a0v[1] = q0.y; a0v[2] = q0.z; a0v[3] = q0.w; a0v[4] = q1.x; a0v[5] = q1.y; a0v[6] = q1.z; a0v[7] = q1.w; }
      { const float4 q0 = *(const float4*)(p.k_k + hc), q1 = *(const float4*)(p.k_k + hc + 4); kkv[0] = q0.x; kkv[1] = q0.y; kkv[2] = q0.z; kkv[3] = q0.w; kkv[4] = q1.x; kkv[5] = q1.y; kkv[6] = q1.z; kkv[7] = q1.w; }
      { const float4 q0 = *(const float4*)(p.k_a + hc), q1 = *(const float4*)(p.k_a + hc + 4); kav[0] = q0.x; kav[1] = q0.y; kav[2] = q0.z; kav[3] = q0.w; kav[4] = q1.x; kav[5] = q1.y; kav[6] = q1.z; kav[7] = q1.w; }
      { const float4 q0 = *(const float4*)(p.r_k + hc), q1 = *(const float4*)(p.r_k + hc + 4); rkv[0] = q0.x; rkv[1] = q0.y; rkv[2] = q0.z; rkv[3] = q0.w; rkv[4] = q1.x; rkv[5] = q1.y; rkv[6] = q1.z; rkv[7] = q1.w; }
      float ld[8], aa[8], kk[8]; float ssq = 0.f;
#pragma unroll
      for (int e = 0; e < 8; ++e) {
          const float xx = w0v[e] + dl[e];
          const float sp = fmaxf(-xx, 0.f) + log1pf(__expf(-fabsf(xx)));
          ld[e] = -__expf(-sp - 0.5f);
          aa[e] = 1.f / (1.f + __expf(-(a0v[e] + al[e])));
          kk[e] = k8[e] * kkv[e]; ssq += kk[e] * kk[e];
      }
      ssq += __shfl_xor(ssq, 1); ssq += __shfl_xor(ssq, 2); ssq += __shfl_xor(ssq, 4);
      const float kinv = 1.f / fmaxf(sqrtf(ssq), 1e-12f);
      float bon = 0.f;
#pragma unroll
      for (int e = 0; e < 8; ++e) { kk[e] *= kinv; k8[e] = k8[e] * (1.f + (aa[e] - 1.f) * kav[e]); bon += r8[e] * k8[e] * rkv[e]; av8[e] = -kk[e]; bv8[e] = kk[e] * aa[e]; }
      bon += __shfl_xor(bon, 1); bon += __shfl_xor(bon, 2); bon += __shfl_xor(bon, 4);
      float bv[8];
#pragma unroll
      for (int e = 0; e < 8; ++e) bv[e] = bon * v8[e];
      const size_t go = (size_t)item * 4096 + t * 64 + jg * 8;
      *(u32x4*)((bf16_t*)(p.ws + WS_GATE) + go) = pack8(gg);
      *(u32x4*)((bf16_t*)(p.ws + WS_BONUS) + go) = pack8(bv);
      *(LAS f32x4*)(lds + R_DL + t * FS + jg * 32) = (f32x4){ld[0], ld[1], ld[2], ld[3]};
      *(LAS f32x4*)(lds + R_DL + t * FS + jg * 32 + 16) = (f32x4){ld[4], ld[5], ld[6], ld[7]};
    }
    __syncthreads();
    { const int j = tid & 63, seg = tid >> 6; float run = 0.f;
#pragma unroll
      for (int i = 0; i < 8; ++i) { LAS float* q = (LAS float*)(lds + R_DL + (seg * 8 + i) * FS + j * 4); run += *q; *q = run; }
      *(LAS float*)(lds + R_SEG + (seg * 64 + j) * 4) = run;
      __syncthreads();
      float pre = 0.f;
      for (int s2 = 0; s2 < seg; ++s2) pre += *(const LAS float*)(lds + R_SEG + (s2 * 64 + j) * 4);
#pragma unroll
      for (int i = 0; i < 8; ++i) { LAS float* q = (LAS float*)(lds + R_DL + (seg * 8 + i) * FS + j * 4); *q += pre; } }
    __syncthreads();
    { float L[8], Lp[8], LC[8];
      { const f32x4 x0 = *(const LAS f32x4*)(lds + R_DL + t * FS + jg * 32), x1 = *(const LAS f32x4*)(lds + R_DL + t * FS + jg * 32 + 16);
        const f32x4 c0 = *(const LAS f32x4*)(lds + R_DL + 63 * FS + jg * 32), c1 = *(const LAS f32x4*)(lds + R_DL + 63 * FS + jg * 32 + 16);
        f32x4 p0 = {0.f, 0.f, 0.f, 0.f}, p1 = p0;
        if (t > 0) { p0 = *(const LAS f32x4*)(lds + R_DL + (t - 1) * FS + jg * 32); p1 = *(const LAS f32x4*)(lds + R_DL + (t - 1) * FS + jg * 32 + 16); }
#pragma unroll
        for (int e = 0; e < 4; ++e) { L[e] = x0[e]; L[4 + e] = x1[e]; LC[e] = c0[e]; LC[4 + e] = c1[e]; Lp[e] = p0[e]; Lp[4 + e] = p1[e]; } }
      float at[8], bt[8], kt[8], rt[8];
#pragma unroll
      for (int e = 0; e < 8; ++e) {
          const float eL = __expf(L[e]), eLp = __expf(Lp[e]), einv = __expf(-L[e]), eC = __expf(LC[e] - L[e]);
          at[e] = av8[e] * eLp; bt[e] = bv8[e] * einv; kt[e] = k8[e] * einv; rt[e] = r8[e] * eL;
          const int ch = jg * 8 + e;
          *(LAS unsigned short*)(lds + R_VT + ch * TS + t * 2) = f2bf(v8[e]);
          *(LAS unsigned short*)(lds + R_BH + ch * TS + t * 2) = f2bf(bv8[e] * eC);
          *(LAS unsigned short*)(lds + R_KH + ch * TS + t * 2) = f2bf(k8[e] * eC);
          if (t == 63) ((float*)(p.ws + WS_GAM))[(size_t)item * 64 + ch] = __expf(LC[e]);
      }
      *(LAS f32x4*)(lds + R_RHS + t * RS + jg * 32) = (f32x4){at[0], at[1], at[2], at[3]};
      *(LAS f32x4*)(lds + R_RHS + t * RS + jg * 32 + 16) = (f32x4){at[4], at[5], at[6], at[7]};
      *(LAS u32x4*)(lds + R_AT + t * TS + jg * 16) = pack8(at);
      *(LAS u32x4*)(lds + R_BT + t * TS + jg * 16) = pack8(bt);
      *(LAS u32x4*)(lds + R_KT + t * TS + jg * 16) = pack8(kt);
      *(LAS u32x4*)(lds + R_RT + t * TS + jg * 16) = pack8(rt);
    }
    __syncthreads();
    { const int mat = wid >> 1;
      const LAS unsigned char* Aop = lds + ((mat < 2) ? R_AT : R_RT);
      const LAS unsigned char* Bop = lds + ((mat & 1) ? R_KT : R_BT);
      const int incl = (mat >= 2) ? 1 : 0;
#pragma unroll
      for (int mm = 0; mm < 2; ++mm) { const int m = (wid & 1) * 2 + mm;
#pragma unroll
          for (int n = 0; n < 4; ++n) {
              f32x4 acc = {0.f, 0.f, 0.f, 0.f};
              if (n <= m) acc = mm_lds(Aop, TS, m * 16, Bop, TS, n * 16, 64, lane, acc);
              const int tr = m * 16 + (lane & 15), s0 = n * 16 + 4 * (lane >> 4);
#pragma unroll
              for (int e = 0; e < 4; ++e) if (!(s0 + e < tr + incl)) acc[e] = 0.f;
              if (mat == 0) {
#pragma unroll
                  for (int e = 0; e < 4; ++e) *(LAS float*)(lds + R_AAB + (tr * 64 + e * 16 + n * 4 + (lane >> 4)) * 4) = acc[e];
              } else {
                  const int dst = (mat == 1) ? R_AAK : ((mat == 2) ? R_ARB : R_ARK);
                  *(LAS u32x2*)(lds + dst + tr * TS + s0 * 2) = (u32x2){cvt_pk_bf16(acc[0], acc[1]), cvt_pk_bf16(acc[2], acc[3])};
              }
          } } }
    __syncthreads();
    { const int m = wid >> 1;
#pragma unroll
      for (int nn = 0; nn < 2; ++nn) { const int n = (wid & 1) * 2 + nn;
          f32x4 acc = {0.f, 0.f, 0.f, 0.f};
          acc = mm_lds(lds + R_AAK, TS, m * 16, lds + R_VT, TS, n * 16, 64, lane, acc);
          *(LAS f32x4*)(lds + R_RHS + (m * 16 + (lane & 15)) * RS + (64 + n * 16 + 4 * (lane >> 4)) * 4) = acc; } }
    __syncthreads();
    { const int cc = lane >> 2, q = lane & 3, col = wid * 16 + cc;
      float ur[16];
#pragma unroll
      for (int i = 0; i < 16; ++i) ur[i] = *(const LAS float*)(lds + R_RHS + (4 * i + q) * RS + col * 4);
#pragma unroll
      for (int tt = 1; tt < 64; ++tt) {
          const int nI = (tt + 3) >> 2;
          const LAS unsigned char* ar = lds + R_AAB + (tt * 64 + q * 16) * 4;
          float pp = 0.f;
#pragma unroll
          for (int i4 = 0; i4 < (nI + 3) / 4; ++i4) { const f32x4 a4 = *(const LAS f32x4*)(ar + i4 * 16);
#pragma unroll
              for (int e = 0; e < 4; ++e) if (i4 * 4 + e < nI) pp += a4[e] * ur[i4 * 4 + e]; }
          pp = quad_sum(pp);
          if (q == (tt & 3)) ur[tt >> 2] += pp;
      }
      const int dbase = (col < 64) ? (R_WT + col * TS) : (R_UT + (col - 64) * TS);
#pragma unroll
      for (int i = 0; i < 16; ++i) *(LAS unsigned short*)(lds + dbase + (4 * i + q) * 2) = f2bf(ur[i]);
    }
    __syncthreads();
    { const int o = wid >> 1;
      bf16_t* MPg = (bf16_t*)(p.ws + WS_MP) + (size_t)item * 4096; bf16_t* Pg = (bf16_t*)(p.ws + WS_P) + (size_t)item * 4096;
      float* Qg = p.out + (size_t)item * 4096; float* GTg = p.out + 8388608 + (size_t)item * 4096;
#pragma unroll
      for (int mm = 0; mm < 2; ++mm) { const int m = (wid & 1) * 2 + mm;
#pragma unroll
          for (int n = 0; n < 4; ++n) {
              f32x4 acc = {0.f, 0.f, 0.f, 0.f};
              const int rr = m * 16 + (lane & 15), c0 = n * 16 + 4 * (lane >> 4);
              if (o == 0) { acc = mm_lds(lds + R_BH, TS, m * 16, lds + R_WT, TS, n * 16, 64, lane, acc);
                  *(u32x2*)(MPg + rr * 64 + c0) = (u32x2){cvt_pk_bf16(acc[0], acc[1]), cvt_pk_bf16(acc[2], acc[3])}; }
              else if (o == 1) { acc = mm_lds(lds + R_UT, TS, m * 16, lds + R_BH, TS, n * 16, 64, lane, acc);
                  acc = mm_lds(lds + R_VT, TS, m * 16, lds + R_KH, TS, n * 16, 64, lane, acc);
                  *(f32x4*)(GTg + rr * 64 + c0) = acc; }
              else if (o == 2) { acc = mm_lds(lds + R_ARB, TS, m * 16, lds + R_WT, TS, n * 16, 64, lane, acc);
                  const u32x2 rv = *(const LAS u32x2*)(lds + R_RT + rr * TS + c0 * 2);
                  acc[0] += bf2f(rv[0] & 0xffffu); acc[1] += __uint_as_float(rv[0] & 0xffff0000u); acc[2] += bf2f(rv[1] & 0xffffu); acc[3] += __uint_as_float(rv[1] & 0xffff0000u);
                  *(u32x2*)(Pg + rr * 64 + c0) = (u32x2){cvt_pk_bf16(acc[0], acc[1]), cvt_pk_bf16(acc[2], acc[3])}; }
              else { acc = mm_lds(lds + R_ARB, TS, m * 16, lds + R_UT, TS, n * 16, 64, lane, acc);
                  acc = mm_lds(lds + R_ARK, TS, m * 16, lds + R_VT, TS, n * 16, 64, lane, acc);
                  *(f32x4*)(Qg + rr * 64 + c0) = acc; }
          } } }
    __syncthreads();
}

__device__ void phase_state(LAS unsigned char* lds, const Params& p) {
    const int tid = threadIdx.x, wid = tid >> 6, lane = tid & 63;
    const int bh = blockIdx.x >> 1, half = blockIdx.x & 1, b = bh >> 3, h = bh & 7;
    const int vl = wid >> 2, vb = half * 2 + vl, rb = wid & 3;
    const bf16_t* MP = (const bf16_t*)(p.ws + WS_MP); const float* GT = p.out + 8388608; const float* GAM = (const float*)(p.ws + WS_GAM);
    bf16_t* HST = (bf16_t*)(p.ws + WS_HST);
    const int arow = rb * 16 + (lane & 15), acol = 8 * (lane >> 4);
    const int irow = vb * 16 + (lane & 15), jcol = rb * 16 + 4 * (lane >> 4);
    f32x4 acc = {0.f, 0.f, 0.f, 0.f};
    const size_t item0 = (size_t)(b * 128) * 8 + h;
    constexpr int PD = 8;
    bf16x8 ra0[PD], ra1[PD]; f32x4 rgt[PD], rgm[PD];
#pragma unroll
    for (int u = 0; u < PD; ++u) { const size_t it = item0 + (size_t)u * 8;
        ra0[u] = *(const bf16x8*)(MP + it * 4096 + arow * 64 + acol); ra1[u] = *(const bf16x8*)(MP + it * 4096 + arow * 64 + acol + 32);
        rgt[u] = *(const f32x4*)(GT + it * 4096 + irow * 64 + jcol); rgm[u] = *(const f32x4*)(GAM + it * 64 + jcol); }
    int buf = 0;
    for (int c0 = 0; c0 < 128; c0 += PD) {
#pragma unroll
        for (int u = 0; u < PD; ++u) {
            const size_t item = item0 + (size_t)(c0 + u) * 8;
            const u32x2 pk = {cvt_pk_bf16(acc[0], acc[1]), cvt_pk_bf16(acc[2], acc[3])};
            *(LAS u32x2*)(lds + buf * 4608 + (vl * 16 + (lane & 15)) * TS + jcol * 2) = pk;
            *(u32x2*)(HST + item * 4096 + irow * 64 + jcol) = pk;
            const bf16x8 ca0 = ra0[u], ca1 = ra1[u]; const f32x4 cgt = rgt[u], cgm = rgm[u];
            if (c0 + PD < 128) { const size_t ni = item + (size_t)PD * 8;
                ra0[u] = *(const bf16x8*)(MP + ni * 4096 + arow * 64 + acol); ra1[u] = *(const bf16x8*)(MP + ni * 4096 + arow * 64 + acol + 32);
                rgt[u] = *(const f32x4*)(GT + ni * 4096 + irow * 64 + jcol); rgm[u] = *(const f32x4*)(GAM + ni * 64 + jcol); }
            __syncthreads();
            const bf16x8 b0 = *(const LAS bf16x8*)(lds + buf * 4608 + (vl * 16 + (lane & 15)) * TS + (lane >> 4) * 16);
            const bf16x8 b1 = *(const LAS bf16x8*)(lds + buf * 4608 + (vl * 16 + (lane & 15)) * TS + (lane >> 4) * 16 + 64);
            acc = cgm * acc + cgt;
            acc = __builtin_amdgcn_mfma_f32_16x16x32_bf16(ca0, b0, acc, 0, 0, 0);
            acc = __builtin_amdgcn_mfma_f32_16x16x32_bf16(ca1, b1, acc, 0, 0, 0);
            buf ^= 1;
        }
    }
}

__device__ void phase_out(const Params& p) {
    const int tid = threadIdx.x, wid = tid >> 6, lane = tid & 63, sub = wid >> 2, mt = wid & 3;
    const bf16_t* Pm = (const bf16_t*)(p.ws + WS_P); const bf16_t* HST = (const bf16_t*)(p.ws + WS_HST); const float* Q = p.out;
    const bf16_t* GA = (const bf16_t*)(p.ws + WS_GATE); const bf16_t* BO = (const bf16_t*)(p.ws + WS_BONUS); bf16_t* mix = (bf16_t*)(p.ws + WS_MIX);
    for (int u = (int)blockIdx.x; u < 1024; u += (int)gridDim.x) {
        const size_t item = (size_t)u * 2 + sub; const int h = (int)(item & 7), c = (int)((item >> 3) & 127), b = (int)(item >> 10);
        const int tr = mt * 16 + (lane & 15);
        const bf16x8 a0 = *(const bf16x8*)(Pm + item * 4096 + tr * 64 + 8 * (lane >> 4)), a1 = *(const bf16x8*)(Pm + item * 4096 + tr * 64 + 8 * (lane >> 4) + 32);
        f32x4 y[4]; float s = 0.f;
#pragma unroll
        for (int n = 0; n < 4; ++n) {
            const bf16_t* hp = HST + item * 4096 + (n * 16 + (lane & 15)) * 64 + 8 * (lane >> 4);
            const bf16x8 b0 = *(const bf16x8*)hp, b1 = *(const bf16x8*)(hp + 32);
            f32x4 acc = *(const f32x4*)(Q + item * 4096 + tr * 64 + n * 16 + 4 * (lane >> 4));
            acc = __builtin_amdgcn_mfma_f32_16x16x32_bf16(b0, a0, acc, 0, 0, 0);
            acc = __builtin_amdgcn_mfma_f32_16x16x32_bf16(b1, a1, acc, 0, 0, 0);
            y[n] = acc; s += acc[0] + acc[1] + acc[2] + acc[3];
        }
        s += __shfl_xor(s, 16); s += __shfl_xor(s, 32);
        const float mu = s * (1.f / 64.f); float vs = 0.f;
#pragma unroll
        for (int n = 0; n < 4; ++n)
#pragma unroll
            for (int e = 0; e < 4; ++e) { const float d = y[n][e] - mu; vs += d * d; }
        vs += __shfl_xor(vs, 16); vs += __shfl_xor(vs, 32);
        const float rstd = rsqrtf(vs * (1.f / 64.f) + 64e-5f);
        const size_t orow = (size_t)(b * SEQ + c * 64 + tr) * DM + 512 + h * 64;
#pragma unroll
        for (int n = 0; n < 4; ++n) { const int i0 = n * 16 + 4 * (lane >> 4);
            const float4 lw = *(const float4*)(p.lnx_w + h * 64 + i0), lb = *(const float4*)(p.lnx_b + h * 64 + i0);
            const u32x2 gv = *(const u32x2*)(GA + item * 4096 + tr * 64 + i0), bv = *(const u32x2*)(BO + item * 4096 + tr * 64 + i0);
            const float g0 = bf2f(gv[0] & 0xffffu), g1 = __uint_as_float(gv[0] & 0xffff0000u), g2 = bf2f(gv[1] & 0xffffu), g3 = __uint_as_float(gv[1] & 0xffff0000u);
            const float o0 = bf2f(bv[0] & 0xffffu), o1 = __uint_as_float(bv[0] & 0xffff0000u), o2 = bf2f(bv[1] & 0xffffu), o3 = __uint_as_float(bv[1] & 0xffff0000u);
            const float r0 = ((y[n][0] - mu) * rstd * lw.x + lb.x + o0) * g0, r1 = ((y[n][1] - mu) * rstd * lw.y + lb.y + o1) * g1,
                        r2 = ((y[n][2] - mu) * rstd * lw.z + lb.z + o2) * g2, r3 = ((y[n][3] - mu) * rstd * lw.w + lb.w + o3) * g3;
            *(u32x2*)(mix + orow + i0) = (u32x2){cvt_pk_bf16(r0, r1), cvt_pk_bf16(r2, r3)}; }
    }
}


#ifndef DIAG
#define DIAG 0
#endif
__device__ void dump_bf16(const bf16_t* src, int ld, int coff, float* out) {
    for (size_t i = (size_t)blockIdx.x * 512 + threadIdx.x; i < (size_t)MTOK * DM; i += (size_t)gridDim.x * 512) {
        const size_t r = i >> 10, c = i & 1023; float v = bf2f(src[r * ld + coff + c]); if (!(v == v) || fabsf(v) > 1e30f) v = 7777.f; out[i] = v; }
}
__global__ void __launch_bounds__(512, 2) fwd_megakernel(Params p) {
    extern __shared__ __attribute__((aligned(16))) unsigned char shm[];
    LAS unsigned char* lds = (LAS unsigned char*)shm;
    cg::grid_group grid = cg::this_grid();
    if (p.ws == nullptr) grid.sync();
    if (threadIdx.x < 4) *(volatile LAS unsigned*)(lds + LDS_ST + threadIdx.x * 4) = 0u;
    __syncthreads();
    const XcdBarrier xbar = xcd_barrier_post((unsigned*)(p.ws + WS_BAR), (volatile LAS unsigned*)(lds + LDS_ST));
#define GSYNC() xcd_barrier(xbar)
    float* mod = (float*)(p.ws + WS_MOD);
    phase0(lds, p);
    GSYNC();
    phase_norm(p.x, p.norm1_g, mod, 0, 1024, (bf16_t*)(p.ws + WS_H));
    GSYNC();
    { EpiZ e; e.O = (bf16_t*)(p.ws + WS_Z); e.ldc = INC; run_gemm(lds, (const bf16_t*)(p.ws + WS_H), (const bf16_t*)(p.ws + WS_WIN), INC, 1024, e); }
    GSYNC();
    if (DIAG == 2) { dump_bf16((const bf16_t*)(p.ws + WS_Z), INC, 0, p.out); return; }
    if (DIAG == 3) { dump_bf16((const bf16_t*)(p.ws + WS_Z), INC, 1024, p.out); return; }
    for (int it = (int)blockIdx.x; it < 2048; it += (int)gridDim.x) scan_pre_item(lds, p, it);
    GSYNC();
    if (blockIdx.x < 32) phase_state(lds, p);
    else for (int it = (int)blockIdx.x - 32; it < 1024; it += (int)gridDim.x - 32) pool_item(lds, p, it >> 2, it & 3);
    GSYNC();
    phase_out(p);
    GSYNC();
    if (DIAG == 5) { dump_bf16((const bf16_t*)(p.ws + WS_MIX), DM, 0, p.out); return; }
    { EpiRes e; e.xin = p.x; e.out = p.out; e.gate = mod + 2048; run_gemm(lds, (const bf16_t*)(p.ws + WS_MIX), (const bf16_t*)(p.ws + WS_WOUT), 1024, 1024, e); }
    GSYNC();
    phase_norm(p.out, p.norm2_g, mod, 3072, 4096, (bf16_t*)(p.ws + WS_H));
    GSYNC();
    { EpiAct e; e.O = (bf16_t*)(p.ws + WS_ACT); run_gemm(lds, (const bf16_t*)(p.ws + WS_H), (const bf16_t*)(p.ws + WS_WGU), 2 * DFF, 1024, e); }
    GSYNC();
    { EpiRes e; e.xin = p.out; e.out = p.out; e.gate = mod + 5120; run_gemm(lds, (const bf16_t*)(p.ws + WS_ACT), (const bf16_t*)(p.ws + WS_WDN), 1024, DFF, e); }
    GSYNC();
    phase_final(p.out, p.final_g);
}

extern "C" void kernel_launch(void* const* d_in, const int* in_sizes, int n_in, void* d_out, int out_size, void* d_ws, size_t ws_size, hipStream_t stream) {
    static int grid_blocks = 0;
    if (!grid_blocks) {
        int dev = 0, cus = 0, per_cu = 0;
        hipGetDevice(&dev);
        hipDeviceGetAttribute(&cus, hipDeviceAttributeMultiprocessorCount, dev);
        hipFuncSetAttribute((const void*)fwd_megakernel, hipFuncAttributeMaxDynamicSharedMemorySize, LDS_BYTES);
        hipOccupancyMaxActiveBlocksPerMultiprocessor(&per_cu, (const void*)fwd_megakernel, 512, LDS_BYTES);
        if (per_cu < 1) { fprintf(stderr, "occupancy query says %d blocks/CU\n", per_cu); per_cu = 1; }
        grid_blocks = cus * 1;
        (void)hipGetLastError();
    }
    Params p{};
    const float** f = (const float**)&p;
    for (int i = 0; i < 24; ++i) f[i] = (const float*)d_in[i];
    p.out = (float*)d_out; p.ws = (unsigned char*)d_ws;
    (void)hipMemsetAsync((unsigned char*)d_ws + WS_BAR, 0, XCD_BAR_WORDS * sizeof(unsigned), stream);
    void* args[] = {&p};
    hipError_t e = hipLaunchCooperativeKernel((const void*)fwd_megakernel, dim3(grid_blocks), dim3(512), args, LDS_BYTES, stream);
    if (e != hipSuccess) fprintf(stderr, "cooperative launch failed: %s (grid %d)\n", hipGetErrorString(e), grid_blocks);
}
```

```cpp
#include <hip/hip_runtime.h>
#include <hip/hip_cooperative_groups.h>
#include <cstdio>
namespace cg = cooperative_groups;
namespace pg8 {
#define PG8_LAS __attribute__((address_space(3)))
typedef unsigned short bf16_t;
typedef short bf16x8 __attribute__((ext_vector_type(8)));
typedef float f32x4 __attribute__((ext_vector_type(4)));
typedef unsigned u32x4 __attribute__((ext_vector_type(4)));
constexpr int BM = 256, BK = 64, HALF = 128, HTB = HALF * BK * 2  , STAGE_BYTES = 8 * HTB, NXCD = 8, WGM = 8;

__host__ __device__ __forceinline__ int lds_byte(int r, int c) { const int st = (r >> 4) * 2 + (c >> 5), rr = r & 15, cc = c & 31, ob = rr * 64 + cc * 2; return st * 1024 + (ob ^ (((ob >> 9) & 1) << 5)); }
__host__ __device__ __forceinline__ void stage_rc(int b, int& R, int& C) { const int st = b / 1024, sb = b % 1024, swz = sb ^ (((sb >> 9) & 1) << 5); R = (st >> 1) * 16 + swz / 64; C = (st & 1) * 32 + (swz % 64) / 2; }
__host__ __device__ __forceinline__ int perm32(int rho) { const int n = rho >> 4, i = rho & 15; return 8 * (i >> 2) + 4 * n + (i & 3); }

struct Unit { int pm, pn; };
struct Gemm { const bf16_t* A; const bf16_t* Bt; int M, N, K; };

struct StaticOrder {
    int nM, nN, nwg, G, c;
    __host__ __device__ void init(int M, int N, int G_, int c_) { nM = M / BM; nN = N / BM; nwg = nM * nN; G = G_; c = c_; }
    __host__ __device__ bool next(int i, Unit& u) const {
        const long L = (long)i * G + c; if (L >= nwg) return false;
        int wgid = (int)L; { const int q = nwg / NXCD, r = nwg % NXCD, xcd = wgid % NXCD, off = wgid / NXCD; wgid = (xcd < r ? xcd * (q + 1) : r * (q + 1) + (xcd - r) * q) + off; }
        const int nig = WGM * nN, gid = wgid / nig, fm = gid * WGM, gsz = (nM - fm) < WGM ? (nM - fm) : WGM;
        u.pm = fm + ((wgid % nig) % gsz); u.pn = (wgid % nig) / gsz; return true;
    }
    __device__ __forceinline__ void a_ready(const Unit&) const {}
    __device__ __forceinline__ void done(const Unit&) const {}
};
typedef float f32x2_t __attribute__((ext_vector_type(2)));
typedef __bf16 bf16x2_t __attribute__((ext_vector_type(2)));
__device__ __forceinline__ unsigned cvt_pk_bf16(float lo, float hi) { const f32x2_t v = {lo, hi}; const bf16x2_t r = __builtin_convertvector(v, bf16x2_t); return __builtin_bit_cast(unsigned, r); }

template <class Epi, class Sched, bool STAMP = false>
__device__ __forceinline__ void gemm_phase(PG8_LAS unsigned char* lds, const Gemm g, const Sched& S, const Epi& E, unsigned long long* stamps) {
    const int tid = threadIdx.x, wid = __builtin_amdgcn_readfirstlane(tid >> 6), lane = tid & 63, wr = wid >> 2, wc = wid & 3, fr = lane & 15, fq = lane >> 4;
    const int K = g.K, nt = K / BK;
    int ts_lo = 0, ts_hi = 0, nts = 0; const unsigned long long rt_entry = STAMP ? (unsigned long long)wall_clock64() : 0ull;
#define PG8_STAMP() do { if (STAMP && wid == 0 && nts < 64) { const unsigned long long _c = (unsigned long long)clock64(); \
        ts_lo = (lane == nts) ? (int)(unsigned)_c : ts_lo; ts_hi = (lane == nts) ? (int)(unsigned)(_c >> 32) : ts_hi; ++nts; } } while (0)
    PG8_STAMP();
    unsigned voffA[2], voffB[2];
#pragma unroll
    for (int i = 0; i < 2; ++i) { int R, C; stage_rc(tid * 16 + i * 8192, R, C); const int Rb = Epi::PERM ? ((R & ~31) + perm32(R & 31)) : R;
        voffA[i] = (unsigned)(R * K + C) * 2u; voffB[i] = (unsigned)(Rb * K + C) * 2u; }
    const size_t kstep = (size_t)(BK * 2);
    const size_t hstep = (size_t)HALF * K * 2;
    const size_t tstep = 2 * hstep;
    const unsigned ldsw = (unsigned)wid * 1024u;
    const int aoff = lds_byte(wr * 64 + fr, fq * 8), boff = lds_byte(wc * 32 + fr, fq * 8);
#define PG8_SA(b, h) (((b) * 2 + (h)) * HTB)
#define PG8_SB(b, h) ((4 + (b) * 2 + (h)) * HTB)
#define PG8_STAGE(bufoff, gbase, voff) do { _Pragma("unroll") for (int _i = 0; _i < 2; ++_i) \
        __builtin_amdgcn_global_load_lds((const unsigned*)((const char*)(gbase) + (voff)[_i]), (PG8_LAS unsigned*)(lds + (bufoff) + ldsw + _i * 8192), 16, 0, 0); } while (0)
#define PG8_LDA(dst, b, h) do { _Pragma("unroll") for (int m = 0; m < 4; ++m) _Pragma("unroll") for (int k = 0; k < 2; ++k) dst[m][k] = *(const PG8_LAS bf16x8*)(lds + PG8_SA(b, h) + aoff + m * 2048 + k * 1024); } while (0)
#define PG8_LDB(dst, b, h) do { _Pragma("unroll") for (int n = 0; n < 2; ++n) _Pragma("unroll") for (int k = 0; k < 2; ++k) dst[n][k] = *(const PG8_LAS bf16x8*)(lds + PG8_SB(b, h) + boff + n * 2048 + k * 1024); } while (0)
#define PG8_MMA(ai, bj, At, Bt) do { __builtin_amdgcn_s_setprio(1); _Pragma("unroll") for (int m = 0; m < 4; ++m) _Pragma("unroll") for (int n = 0; n < 2; ++n) _Pragma("unroll") for (int k = 0; k < 2; ++k) \
        acc[ai][bj][m][n] = __builtin_amdgcn_mfma_f32_16x16x32_bf16(Bt[n][k], At[m][k], acc[ai][bj][m][n], 0, 0, 0); __builtin_amdgcn_s_setprio(0); } while (0)
#define PG8_WAIT_V(n) asm volatile("s_waitcnt vmcnt(" #n ")" ::: "memory")
#define PG8_WAIT_L(n) asm volatile("s_waitcnt lgkmcnt(" #n ")" ::: "memory")
#define PG8_BAR __builtin_amdgcn_s_barrier()
#define PG8_SCHED __builtin_amdgcn_sched_barrier(0)
    Unit cur, nxt; int ui = 0;
    if (!S.next(0, cur)) return;
    f32x4 acc[2][2][4][2];
#pragma unroll
    for (int a = 0; a < 2; ++a)
#pragma unroll
        for (int b = 0; b < 2; ++b)
#pragma unroll
            for (int m = 0; m < 4; ++m)
#pragma unroll
                for (int n = 0; n < 2; ++n) acc[a][b][m][n] = (f32x4){0.f, 0.f, 0.f, 0.f};
    bf16x8 At[4][2], B0[2][2], B1[2][2];
    const char* cA = (const char*)g.A + (size_t)cur.pm * tstep; const char* cB = (const char*)g.Bt + (size_t)cur.pn * tstep;
    S.a_ready(cur);
    PG8_STAGE(PG8_SB(0, 0), cB, voffB); PG8_STAGE(PG8_SA(0, 0), cA, voffA); PG8_STAGE(PG8_SB(0, 1), cB + hstep, voffB); PG8_STAGE(PG8_SA(0, 1), cA + hstep, voffA);
    if (wr == 1) PG8_BAR;
    PG8_WAIT_V(4); PG8_BAR;
    PG8_STAGE(PG8_SB(1, 0), cB + kstep, voffB); PG8_STAGE(PG8_SA(1, 0), cA + kstep, voffA); PG8_STAGE(PG8_SB(1, 1), cB + hstep + kstep, voffB);
    PG8_WAIT_V(6); PG8_BAR;
    PG8_STAMP();
    for (;;) {
        const bool has_next = S.next(ui + 1, nxt);
        const char* nA = has_next ? (const char*)g.A + (size_t)nxt.pm * tstep : cA; const char* nB = has_next ? (const char*)g.Bt + (size_t)nxt.pn * tstep : cB;
        for (int t = 0; t < nt; t += 2) {
            const bool last = (t == nt - 2);
            const char* a1 = cA + (size_t)(t + 1) * kstep;
            const char* a2 = last ? nA : cA + (size_t)(t + 2) * kstep; const char* b2 = last ? nB : cB + (size_t)(t + 2) * kstep;
            const char* a3 = a2 + kstep; const char* b3 = b2 + kstep;
            if (last && has_next) S.a_ready(nxt);
            PG8_LDB(B0, 0, 0); PG8_SCHED; PG8_LDA(At, 0, 0); PG8_STAGE(PG8_SA(1, 1), a1 + hstep, voffA);
            PG8_WAIT_L(8); PG8_BAR; PG8_WAIT_L(0); PG8_MMA(0, 0, At, B0); PG8_BAR; PG8_SCHED;
            PG8_LDB(B1, 0, 1); PG8_STAGE(PG8_SB(0, 0), b2, voffB);
            PG8_BAR; PG8_WAIT_L(0); PG8_MMA(0, 1, At, B1); PG8_BAR;
            PG8_LDA(At, 0, 1); PG8_STAGE(PG8_SA(0, 0), a2, voffA);
            PG8_BAR; PG8_WAIT_L(0); PG8_MMA(1, 0, At, B0); PG8_BAR; PG8_SCHED;
            PG8_STAGE(PG8_SB(0, 1), b2 + hstep, voffB);
            PG8_WAIT_V(6); PG8_BAR; PG8_MMA(1, 1, At, B1); PG8_BAR;
            PG8_LDB(B0, 1, 0); PG8_SCHED; PG8_LDA(At, 1, 0); PG8_STAGE(PG8_SA(0, 1), a2 + hstep, voffA);
            PG8_WAIT_L(8); PG8_BAR; PG8_WAIT_L(0); PG8_MMA(0, 0, At, B0); PG8_BAR; PG8_SCHED;
            PG8_LDB(B1, 1, 1); PG8_STAGE(PG8_SB(1, 0), b3, voffB);
            PG8_BAR; PG8_WAIT_L(0); PG8_MMA(0, 1, At, B1); PG8_BAR;
            PG8_LDA(At, 1, 1); PG8_STAGE(PG8_SA(1, 0), a3, voffA);
            PG8_BAR; PG8_WAIT_L(0); PG8_MMA(1, 0, At, B0); PG8_BAR; PG8_SCHED;
            PG8_STAGE(PG8_SB(1, 1), b3 + hstep, voffB);
            PG8_WAIT_V(6); PG8_BAR; PG8_MMA(1, 1, At, B1); PG8_BAR;
        }
        PG8_STAMP();
        if constexpr (!Epi::AFTER_DRAIN) { E(acc, cur, wr, wc, fr, fq); S.done(cur); }
        PG8_STAMP();
        if (!has_next) break;
#pragma unroll
        for (int a = 0; a < 2; ++a)
#pragma unroll
            for (int b = 0; b < 2; ++b)
#pragma unroll
                for (int m = 0; m < 4; ++m)
#pragma unroll
                    for (int n = 0; n < 2; ++n) acc[a][b][m][n] = (f32x4){0.f, 0.f, 0.f, 0.f};
        cur = nxt; cA = nA; cB = nB; ++ui;
    }
    PG8_WAIT_V(0);
    if (wr == 0) PG8_BAR;
    PG8_BAR;
    if constexpr (Epi::AFTER_DRAIN) { E.fused(acc, cur, wr, wc, fr, fq, lds, wid, lane); S.done(cur); }
    PG8_STAMP();
    if (STAMP && wid == 0) { stamps[lane] = lane < nts ? (((unsigned long long)(unsigned)ts_hi << 32) | (unsigned)ts_lo) : 0ull;
        if (lane == 62) stamps[62] = rt_entry; if (lane == 63) stamps[63] = (unsigned long long)wall_clock64(); }
#undef PG8_STAMP
#undef PG8_SA
#undef PG8_SB
#undef PG8_STAGE
#undef PG8_LDA
#undef PG8_LDB
#undef PG8_MMA
#undef PG8_WAIT_V
#undef PG8_WAIT_L
#undef PG8_BAR
#undef PG8_SCHED
}
}

using pg8::bf16_t; using pg8::bf16x8; using pg8::f32x4; using pg8::u32x4; using pg8::cvt_pk_bf16;
#define LAS __attribute__((address_space(3)))
typedef unsigned u32x2 __attribute__((ext_vector_type(2)));

constexpr int MTOK = 16384, DM = 1024, INC = 2304, DFF = 2816, SEQ = 8192;
constexpr size_t MiB = 1ull << 20;
constexpr size_t WS_WIN = 0, WS_WOUT = 4718592, WS_WGU = 6815744, WS_WDN = 18350080, WS_WPOOL = 24117248, WS_WDEC = 24248320,
                 WS_WICLR = 24313856, WS_WGATE = 24379392, WS_MOD = 24510464, WS_GAM = 24559616,
                 WS_H = 24 * MiB, WS_MP = 24 * MiB, WS_P = 40 * MiB, WS_Z = 56 * MiB, WS_ACT = 56 * MiB, WS_GATE = 128 * MiB,
                 WS_BONUS = 144 * MiB, WS_HST = 160 * MiB, WS_MIX = 176 * MiB;
constexpr int LDS_ST = 143360;
constexpr int LDS_BYTES = 143376;
constexpr size_t WS_BAR = 208 * MiB;
constexpr int TS = 144;
constexpr int R_AT = 0, R_BT = 9216, R_KT = 18432, R_RT = 27648, R_VT = 36864, R_BH = 46080, R_KH = 55296, R_AAK = 64512, R_ARB = 73728, R_ARK = 82944,
              R_AAB = 92160, R_RHS = 108544;
constexpr int R_TX = R_AT, R_XA = R_BT, R_SG = R_KT  , R_WT = R_AT, R_UT = R_BT;
constexpr int R_DL = R_AAK  , R_SEG = R_ARK, R_AL = R_RHS, R_GG = R_RHS + 17408;
constexpr int FS = 272;
constexpr int RS = 544;

struct Params {
    const float *x, *c, *ada_w, *ada_b, *norm1_g, *w_in, *mu_shift, *pool_w, *pool_scale, *w0, *w_decay_up, *a0, *w_iclr_up, *w_gate_up,
                *k_k, *k_a, *r_k, *lnx_w, *lnx_b, *w_out, *norm2_g, *w_ffn_gu, *w_ffn_down, *final_g;
    float* out; unsigned char* ws;
};

__device__ __forceinline__ float bf2f(unsigned v) { return __uint_as_float(v << 16); }
__device__ __forceinline__ float wave_sum(float v) {
#pragma unroll
    for (int o = 32; o > 0; o >>= 1) v += __shfl_xor(v, o);
    return v;
}
__device__ __forceinline__ float quad_sum(float v) {
    int t = __builtin_amdgcn_update_dpp(0, __float_as_int(v), 0xB1, 0xF, 0xF, true); v += __int_as_float(t);
    t = __builtin_amdgcn_update_dpp(0, __float_as_int(v), 0x4E, 0xF, 0xF, true); v += __int_as_float(t);
    return v;
}
__device__ __forceinline__ void unpack8(u32x4 v, float (&f)[8]) {
#pragma unroll
    for (int i = 0; i < 4; ++i) { f[2 * i] = __uint_as_float(v[i] << 16); f[2 * i + 1] = __uint_as_float(v[i] & 0xffff0000u); }
}
__device__ __forceinline__ u32x4 pack8(const float (&f)[8]) { return (u32x4){cvt_pk_bf16(f[0], f[1]), cvt_pk_bf16(f[2], f[3]), cvt_pk_bf16(f[4], f[5]), cvt_pk_bf16(f[6], f[7])}; }
__device__ __forceinline__ unsigned short f2bf(float f) { return (unsigned short)(cvt_pk_bf16(f, 0.f) & 0xffffu); }

__device__ __forceinline__ f32x4 mm_lds(const LAS unsigned char* A, int sa, int m0, const LAS unsigned char* Bt, int sb, int n0, int K, int lane, f32x4 acc) {
    const LAS unsigned char* ap = A + (m0 + (lane & 15)) * sa + (lane >> 4) * 16;
    const LAS unsigned char* bp = Bt + (n0 + (lane & 15)) * sb + (lane >> 4) * 16;
#pragma unroll
    for (int k0 = 0; k0 < K; k0 += 32) {
        const bf16x8 a = *(const LAS bf16x8*)(ap + k0 * 2), b = *(const LAS bf16x8*)(bp + k0 * 2);
        acc = __builtin_amdgcn_mfma_f32_16x16x32_bf16(b, a, acc, 0, 0, 0);
    }
    return acc;
}
__device__ __forceinline__ f32x4 mm_lds_g(const LAS unsigned char* A, int sa, int m0, const unsigned char* Bt, int sb, int n0, int K, int lane, f32x4 acc) {
    const LAS unsigned char* ap = A + (m0 + (lane & 15)) * sa + (lane >> 4) * 16;
    const unsigned char* bp = Bt + (size_t)(n0 + (lane & 15)) * sb + (lane >> 4) * 16;
#pragma unroll
    for (int k0 = 0; k0 < K; k0 += 32) {
        const bf16x8 a = *(const LAS bf16x8*)(ap + k0 * 2), b = *(const bf16x8*)(bp + k0 * 2);
        acc = __builtin_amdgcn_mfma_f32_16x16x32_bf16(b, a, acc, 0, 0, 0);
    }
    return acc;
}

#define XB_TMO      128
#define XB_XCNT(j)  (256  + 64 * (j))
#define XB_XSUB(j)  (1280 + 64 * (j))
#define XB_XGEN(j)  (2304 + 64 * (j))
#define XB_TOP      3328
#define XB_TOPGEN   3392
#define XCD_BAR_WORDS 3456
#define XB_SPIN_CAP (1u << 18)

__device__ __forceinline__ unsigned xb_ld(unsigned* p)              { return __hip_atomic_load(p, __ATOMIC_RELAXED, __HIP_MEMORY_SCOPE_AGENT); }
__device__ __forceinline__ unsigned xb_add(unsigned* p, unsigned v) { return __hip_atomic_fetch_add(p, v, __ATOMIC_RELAXED, __HIP_MEMORY_SCOPE_AGENT); }
__device__ __forceinline__ unsigned xb_xcc_id() { return (unsigned)__builtin_amdgcn_s_getreg((3 << 11) | 20) & 0xFu; }
#define XB_SPIN(cond, bar) do { unsigned _sp = 0; while (cond) { __builtin_amdgcn_s_sleep(1); \
    if ((++_sp & 255u) == 0u) { if (xb_ld(&(bar)[XB_TMO])) break; if (_sp > XB_SPIN_CAP) { atomicAdd(&(bar)[XB_TMO], 1u); break; } } } } while (0)

struct XcdBarrier {
    unsigned* bar; unsigned x;
    volatile LAS unsigned* st;
};

__device__ __forceinline__ XcdBarrier xcd_barrier_post(unsigned* bar, volatile LAS unsigned* st) {
    XcdBarrier b; b.bar = bar; b.x = xb_xcc_id(); b.st = st;
    if (threadIdx.x == 0) (void)xb_add(&bar[XB_XCNT(b.x)], 1u);
    return b;
}
__device__ __forceinline__ void xcd_barrier_complete(unsigned* bar, unsigned x, unsigned& nloc, unsigned& nx) {
    const unsigned G = gridDim.x * gridDim.y * gridDim.z;
    unsigned sum, cnt, mine, sp = 0u;
    for (;;) {
        sum = 0u; cnt = 0u; mine = 0u;
#pragma unroll
        for (unsigned j = 0; j < 16; ++j) { const unsigned c = xb_ld(&bar[XB_XCNT(j)]); sum += c; cnt += (c > 0u) ? 1u : 0u; mine = (j == x) ? c : mine; }
        if (sum == G) break;
        __builtin_amdgcn_s_sleep(1);
        if ((++sp & 255u) == 0u) { if (xb_ld(&bar[XB_TMO])) break; if (sp > XB_SPIN_CAP) { atomicAdd(&bar[XB_TMO], 1u); break; } }
    }
    nloc = mine > 0u ? mine : 1u; nx = cnt > 0u ? cnt : 1u;
}

__device__ __forceinline__ void xcd_barrier(const XcdBarrier& b) {
    asm volatile("s_waitcnt vmcnt(0)" ::: "memory");
    __syncthreads();
    if (threadIdx.x == 0) {
        unsigned* bar = b.bar;
        __builtin_amdgcn_s_waitcnt(0);
        unsigned nloc = b.st[0], nx = b.st[1];
        if (nloc == 0u) { xcd_barrier_complete(bar, b.x, nloc, nx); b.st[0] = nloc; b.st[1] = nx; }
        const unsigned old = xb_add(&bar[XB_XSUB(b.x)], 1u);
        const unsigned gen = old / nloc;
        if (old + 1u == (gen + 1u) * nloc) {
            __builtin_amdgcn_fence(__ATOMIC_RELEASE, "agent");
            asm volatile("s_waitcnt vmcnt(0)" ::: "memory");
            const unsigned og = xb_add(&bar[XB_TOP], 1u);
            const unsigned tg = og / nx;
            if (og + 1u == (tg + 1u) * nx) xb_add(&bar[XB_TOPGEN], 1u);
            else XB_SPIN(xb_ld(&bar[XB_TOPGEN]) == tg, bar);
            __builtin_amdgcn_fence(__ATOMIC_ACQUIRE, "agent");
            xb_add(&bar[XB_XGEN(b.x)], 1u);
            asm volatile("s_waitcnt vmcnt(0)" ::: "memory");
        } else {
            XB_SPIN(xb_ld(&bar[XB_XGEN(b.x)]) == gen, bar);
            __builtin_amdgcn_fence(__ATOMIC_ACQUIRE, "agent");
            asm volatile("s_waitcnt vmcnt(0)" ::: "memory");
        }
    }
    __syncthreads();
}

struct ConvJob { const float* src; bf16_t* dst; int K, N, mode, kt, nt; };
__device__ __forceinline__ ConvJob conv_job(const Params& p, int t) {
    ConvJob j; j.mode = 0; int loc;
    if (t < 576) { loc = t; j.src = p.w_in; j.dst = (bf16_t*)(p.ws + WS_WIN); j.K = 1024; j.N = INC; }
    else if (t < 592) { const int g = (t - 576) >> 2; loc = (t - 576) & 3; j.src = p.pool_w + g * 16384; j.dst = (bf16_t*)(p.ws + WS_WPOOL) + g * 16384; j.K = 128; j.N = 128; }
    else if (t < 600) { loc = t - 592; j.src = p.w_decay_up; j.dst = (bf16_t*)(p.ws + WS_WDEC); j.K = 64; j.N = 512; }
    else if (t < 608) { loc = t - 600; j.src = p.w_iclr_up; j.dst = (bf16_t*)(p.ws + WS_WICLR); j.K = 64; j.N = 512; }
    else if (t < 624) { loc = t - 608; j.src = p.w_gate_up; j.dst = (bf16_t*)(p.ws + WS_WGATE); j.K = 128; j.N = 512; }
    else if (t < 880) { loc = t - 624; j.src = p.w_out; j.dst = (bf16_t*)(p.ws + WS_WOUT); j.K = 1024; j.N = 1024; }
    else if (t < 2288) { loc = t - 880; j.src = p.w_ffn_gu; j.dst = (bf16_t*)(p.ws + WS_WGU); j.K = 1024; j.N = 2 * DFF; j.mode = 1; }
    else { loc = t - 2288; j.src = p.w_ffn_down; j.dst = (bf16_t*)(p.ws + WS_WDN); j.K = DFF; j.N = 1024; }
    const int ntn = j.N / 64; j.kt = loc / ntn; j.nt = loc % ntn; return j;
}
__device__ void conv_run(LAS float* tile, const Params& p, int first, int stride, int hi) {
    const int tid = threadIdx.x, r = tid >> 4, c4 = (tid & 15) * 4, n = tid >> 3, k8 = (tid & 7) * 8;
    if (first >= hi) return;
    ConvJob j = conv_job(p, first);
    float4 v0 = *(const float4*)(j.src + (size_t)(j.kt * 64 + r) * j.N + j.nt * 64 + c4), v1 = *(const float4*)(j.src + (size_t)(j.kt * 64 + r + 32) * j.N + j.nt * 64 + c4);
    for (int t = first; t < hi; t += stride) {
        tile[r * 65 + c4 + 0] = v0.x; tile[r * 65 + c4 + 1] = v0.y; tile[r * 65 + c4 + 2] = v0.z; tile[r * 65 + c4 + 3] = v0.w;
        tile[(r + 32) * 65 + c4 + 0] = v1.x; tile[(r + 32) * 65 + c4 + 1] = v1.y; tile[(r + 32) * 65 + c4 + 2] = v1.z; tile[(r + 32) * 65 + c4 + 3] = v1.w;
        __syncthreads();
        const ConvJob cj = j;
        if (t + stride < hi) { j = conv_job(p, t + stride);
            v0 = *(const float4*)(j.src + (size_t)(j.kt * 64 + r) * j.N + j.nt * 64 + c4); v1 = *(const float4*)(j.src + (size_t)(j.kt * 64 + r + 32) * j.N + j.nt * 64 + c4); }
        float f[8];
#pragma unroll
        for (int e = 0; e < 8; ++e) f[e] = tile[(k8 + e) * 65 + n];
        const int col = cj.nt * 64 + n; int drow = col;
        if (cj.mode == 1) drow = col < DFF ? (col / 128) * 256 + (col % 128) : ((col - DFF) / 128) * 256 + 128 + ((col - DFF) % 128);
        *(u32x4*)(cj.dst + (size_t)drow * cj.K + cj.kt * 64 + k8) = pack8(f);
        __syncthreads();
    }
}
__device__ __forceinline__ void mod_unit(LAS float* red, const Params& p, int u) {
    const int tid = threadIdx.x, w = tid >> 6, lane = tid & 63, cu = u >> 1, kh = u & 1, n = cu * 64 + lane;
    float a0 = 0.f, a1 = 0.f;
    const int kb = kh * 512 + w * 64;
#pragma unroll 16
    for (int k = kb; k < kb + 64; ++k) {
        const float wv = p.ada_w[(size_t)k * 6144 + n]; const float c0 = p.c[k], c1 = p.c[1024 + k];
        a0 += (c0 / (1.f + __expf(-c0))) * wv; a1 += (c1 / (1.f + __expf(-c1))) * wv;
    }
    red[(w * 2 + 0) * 64 + lane] = a0; red[(w * 2 + 1) * 64 + lane] = a1;
    __syncthreads();
    if (tid < 128) { const int b = tid >> 6; float s = 0.f;
#pragma unroll
        for (int w2 = 0; w2 < 8; ++w2) s += red[(w2 * 2 + b) * 64 + lane];
        if (kh == 0) s += p.ada_b[n];
        atomicAdd((float*)(p.ws + WS_MOD) + b * 6144 + n, s); }
    __syncthreads();
}
__device__ void phase0(LAS unsigned char* lds, const Params& p) {
    if (blockIdx.x < 192) mod_unit((LAS float*)lds, p, blockIdx.x);
    conv_run((LAS float*)lds, p, (int)blockIdx.x, (int)gridDim.x, 624);
}

__device__ void phase_norm(const float* X, const float* g, const float* mod, int sh_off, int sc_off, bf16_t* H) {
    const int wid = threadIdx.x >> 6, lane = threadIdx.x & 63;
    for (int row = (int)blockIdx.x * 8 + wid; row < MTOK; row += (int)gridDim.x * 8) {
        const int b = row >> 13; const float* xr = X + (size_t)row * DM; const float* mb = mod + b * 6144;
        float4 v[4]; float ss = 0.f;
#pragma unroll
        for (int j = 0; j < 4; ++j) { v[j] = *(const float4*)(xr + (j * 64 + lane) * 4); ss += v[j].x * v[j].x + v[j].y * v[j].y + v[j].z * v[j].z + v[j].w * v[j].w; }
        ss = wave_sum(ss); const float rstd = rsqrtf(ss * (1.f / 1024.f) + 1e-6f);
#pragma unroll
        for (int j = 0; j < 4; ++j) { const int col = (j * 64 + lane) * 4;
            const float4 gg = *(const float4*)(g + col), sc = *(const float4*)(mb + sc_off + col), sh = *(const float4*)(mb + sh_off + col);
            const float h0 = (v[j].x * rstd * gg.x) * (1.f + sc.x) + sh.x, h1 = (v[j].y * rstd * gg.y) * (1.f + sc.y) + sh.y,
                        h2 = (v[j].z * rstd * gg.z) * (1.f + sc.z) + sh.z, h3 = (v[j].w * rstd * gg.w) * (1.f + sc.w) + sh.w;
            *(u32x2*)(H + (size_t)row * DM + col) = (u32x2){cvt_pk_bf16(h0, h1), cvt_pk_bf16(h2, h3)}; }
    }
}
__device__ void phase_final(float* X, const float* g) {
    const int wid = threadIdx.x >> 6, lane = threadIdx.x & 63;
    for (int row = (int)blockIdx.x * 8 + wid; row < MTOK; row += (int)gridDim.x * 8) {
        float* xr = X + (size_t)row * DM;
        float4 v[4]; float ss = 0.f;
#pragma unroll
        for (int j = 0; j < 4; ++j) { v[j] = *(const float4*)(xr + (j * 64 + lane) * 4); ss += v[j].x * v[j].x + v[j].y * v[j].y + v[j].z * v[j].z + v[j].w * v[j].w; }
        ss = wave_sum(ss); const float rstd = rsqrtf(ss * (1.f / 1024.f) + 1e-6f);
#pragma unroll
        for (int j = 0; j < 4; ++j) { const int col = (j * 64 + lane) * 4; const float4 gg = *(const float4*)(g + col);
            *(float4*)(xr + col) = make_float4(v[j].x * rstd * gg.x, v[j].y * rstd * gg.y, v[j].z * rstd * gg.z, v[j].w * rstd * gg.w); }
    }
}

struct EpiZ {
    static constexpr bool PERM = true, AFTER_DRAIN = false;
    bf16_t* O; int ldc;
    __device__ __forceinline__ void operator()(const f32x4 (&acc)[2][2][4][2], const pg8::Unit& u, int wr, int wc, int fr, int fq) const {
        const int row0 = u.pm * 256 + wr * 64 + fr, col0 = u.pn * 256 + wc * 32 + 8 * fq;
#pragma unroll
        for (int ai = 0; ai < 2; ++ai)
#pragma unroll
            for (int m = 0; m < 4; ++m) { bf16_t* rowp = O + (size_t)(row0 + ai * 128 + m * 16) * ldc + col0;
#pragma unroll
                for (int bj = 0; bj < 2; ++bj) { const f32x4 v0 = acc[ai][bj][m][0], v1 = acc[ai][bj][m][1];
                    *(u32x4*)(rowp + bj * 128) = (u32x4){cvt_pk_bf16(v0[0], v0[1]), cvt_pk_bf16(v0[2], v0[3]), cvt_pk_bf16(v1[0], v1[1]), cvt_pk_bf16(v1[2], v1[3])}; } }
    }
};
struct EpiRes {
    static constexpr bool PERM = false, AFTER_DRAIN = false;
    const float* xin; float* out; const float* gate;
    __device__ __forceinline__ void operator()(const f32x4 (&acc)[2][2][4][2], const pg8::Unit& u, int wr, int wc, int fr, int fq) const {
        const int row0 = u.pm * 256 + wr * 64 + fr, col0 = u.pn * 256 + wc * 32 + 4 * fq;
        const float* gb = gate + (u.pm >> 5) * 6144;
        f32x4 gv[2][2];
#pragma unroll
        for (int bj = 0; bj < 2; ++bj)
#pragma unroll
            for (int n = 0; n < 2; ++n) gv[bj][n] = *(const f32x4*)(gb + col0 + bj * 128 + n * 16);
#pragma unroll
        for (int ai = 0; ai < 2; ++ai)
#pragma unroll
            for (int m = 0; m < 4; ++m) { const size_t ro = (size_t)(row0 + ai * 128 + m * 16) * DM + col0;
#pragma unroll
                for (int bj = 0; bj < 2; ++bj)
#pragma unroll
                    for (int n = 0; n < 2; ++n) { const f32x4 xv = *(const f32x4*)(xin + ro + bj * 128 + n * 16);
                        *(f32x4*)(out + ro + bj * 128 + n * 16) = xv + gv[bj][n] * acc[ai][bj][m][n]; } }
    }
};
struct EpiAct {
    static constexpr bool PERM = true, AFTER_DRAIN = false;
    bf16_t* O;
    __device__ __forceinline__ void operator()(const f32x4 (&acc)[2][2][4][2], const pg8::Unit& u, int wr, int wc, int fr, int fq) const {
        const int row0 = u.pm * 256 + wr * 64 + fr, col0 = u.pn * 128 + wc * 32 + 8 * fq;
#pragma unroll
        for (int ai = 0; ai < 2; ++ai)
#pragma unroll
            for (int m = 0; m < 4; ++m) { float r[8];
#pragma unroll
                for (int n = 0; n < 2; ++n)
#pragma unroll
                    for (int e = 0; e < 4; ++e) { const float gt = acc[ai][0][m][n][e], up = acc[ai][1][m][n][e]; r[n * 4 + e] = gt / (1.f + __expf(-gt)) * up; }
                *(u32x4*)(O + (size_t)(row0 + ai * 128 + m * 16) * DFF + col0) = pack8(r); }
    }
};
template <class Epi> __device__ __forceinline__ void run_gemm(LAS unsigned char* lds, const bf16_t* A, const bf16_t* Bt, int N, int K, const Epi& E) {
    pg8::Gemm g; g.A = A; g.Bt = Bt; g.M = MTOK; g.N = N; g.K = K;
    pg8::StaticOrder S; S.init(MTOK, N, (int)gridDim.x, (int)blockIdx.x);
    pg8::gemm_phase<Epi, pg8::StaticOrder, false>(lds, g, S, E, nullptr);
}

__device__ void pool_item(LAS unsigned char* lds, const Params& p, int tt, int g) {
    const int tid = threadIdx.x, t = tid >> 3, cgp = tid & 7, wid = tid >> 6, lane = tid & 63;
    const bf16_t* Z = (const bf16_t*)(p.ws + WS_Z);
    const int row0 = tt * 64, tl0 = row0 & (SEQ - 1), w = 2 << g;
    constexpr int UOFF = 0, DOFF = 24576;
#pragma unroll
    for (int i = 0; i < 3; ++i) { const int pc = tid + i * 512;
        if (pc < 79 * 16) { const int r = pc >> 4, c16 = pc & 15; const int tl = tl0 - 15 + r;
            u32x4 v = {0u, 0u, 0u, 0u};
            if (tl >= 0) v = *(const u32x4*)(Z + (size_t)(row0 - 15 + r) * INC + g * 128 + c16 * 8);
            *(LAS u32x4*)(lds + UOFF + r * 272 + c16 * 16) = v; } }
    __syncthreads();
    { const int tl = tl0 + t, cnt = (tl + 1) < w ? (tl + 1) : w; const float inv = 1.f / (float)cnt;
      float s0[8], s1[8], u0[8], u1[8];
      const LAS unsigned char* up = lds + UOFF + (t + 15) * 272 + cgp * 32;
      unpack8(*(const LAS u32x4*)up, u0); unpack8(*(const LAS u32x4*)(up + 16), u1);
#pragma unroll
      for (int e = 0; e < 8; ++e) { s0[e] = u0[e]; s1[e] = u1[e]; }
      for (int q = 1; q < w; ++q) { float a[8], b[8]; unpack8(*(const LAS u32x4*)(up - q * 272), a); unpack8(*(const LAS u32x4*)(up - q * 272 + 16), b);
#pragma unroll
          for (int e = 0; e < 8; ++e) { s0[e] += a[e]; s1[e] += b[e]; } }
#pragma unroll
      for (int e = 0; e < 8; ++e) { s0[e] = s0[e] * inv - u0[e]; s1[e] = s1[e] * inv - u1[e]; }
      *(LAS u32x4*)(lds + DOFF + t * 272 + cgp * 32) = pack8(s0); *(LAS u32x4*)(lds + DOFF + t * 272 + cgp * 32 + 16) = pack8(s1); }
    __syncthreads();
    const unsigned char* Bt = p.ws + WS_WPOOL + (size_t)g * 32768;
    const float4 ps = *(const float4*)(p.pool_scale + g * 128 + wid * 16 + 4 * (lane >> 4));
    bf16_t* mix = (bf16_t*)(p.ws + WS_MIX);
#pragma unroll
    for (int m = 0; m < 4; ++m) {
        f32x4 acc = {0.f, 0.f, 0.f, 0.f};
        acc = mm_lds_g(lds + DOFF, 272, m * 16, Bt, 256, wid * 16, 128, lane, acc);
        const int orow = tt * 64 + m * 16 + (lane & 15), ocol = g * 128 + wid * 16 + 4 * (lane >> 4);
        *(u32x2*)(mix + (size_t)orow * DM + ocol) = (u32x2){cvt_pk_bf16(acc[0] * ps.x, acc[1] * ps.y), cvt_pk_bf16(acc[2] * ps.z, acc[3] * ps.w)};
    }
    __syncthreads();
}

__device__ __forceinline__ void shifted8(const bf16_t* Z, int row, bool has_prev, int col, const float* mu_shift, float (&o)[8]) {
    float cur[8], prv[8];
    unpack8(*(const u32x4*)(Z + (size_t)row * INC + col), cur);
    if (has_prev) unpack8(*(const u32x4*)(Z + (size_t)(row - 1) * INC + col), prv);
    else {
#pragma unroll
        for (int e = 0; e < 8; ++e) prv[e] = 0.f; }
    const float4 m0 = *(const float4*)(mu_shift + col - 512), m1 = *(const float4*)(mu_shift + col - 512 + 4);
    const float mu[8] = {m0.x, m0.y, m0.z, m0.w, m1.x, m1.y, m1.z, m1.w};
#pragma unroll
    for (int e = 0; e < 8; ++e) o[e] = cur[e] + (prv[e] - cur[e]) * mu[e];
}
__device__ void scan_pre_item(LAS unsigned char* lds, const Params& p, int item) {
    const int tid = threadIdx.x, t = tid >> 3, jg = tid & 7, wid = __builtin_amdgcn_readfirstlane(tid >> 6), lane = tid & 63;
    const int h = item & 7, c = (item >> 3) & 127, b = item >> 10;
    const bf16_t* Z = (const bf16_t*)(p.ws + WS_Z);
    const int row = b * SEQ + c * 64 + t; const bool has_prev = (c * 64 + t) > 0;
    const int hc = h * 64 + jg * 8;
    float r8[8], k8[8], v8[8];
    shifted8(Z, row, has_prev, 512 + hc, p.mu_shift, r8);
    shifted8(Z, row, has_prev, 1024 + hc, p.mu_shift, k8);
    shifted8(Z, row, has_prev, 1536 + hc, p.mu_shift, v8);
    { float f[8];
      shifted8(Z, row, has_prev, 2048 + jg * 8, p.mu_shift, f);
#pragma unroll
      for (int e = 0; e < 8; ++e) f[e] = 1.f - 2.f * __builtin_amdgcn_rcpf(__expf(2.f * f[e]) + 1.f);
      *(LAS u32x4*)(lds + R_TX + t * TS + jg * 16) = pack8(f);
      shifted8(Z, row, has_prev, 2112 + jg * 8, p.mu_shift, f);
      *(LAS u32x4*)(lds + R_XA + t * TS + jg * 16) = pack8(f);
#pragma unroll
      for (int hh = 0; hh < 2; ++hh) { shifted8(Z, row, has_prev, 2176 + jg * 16 + hh * 8, p.mu_shift, f);
#pragma unroll
          for (int e = 0; e < 8; ++e) f[e] = __builtin_amdgcn_rcpf(1.f + __expf(-f[e]));
          *(LAS u32x4*)(lds + R_SG + t * 272 + jg * 32 + hh * 16) = pack8(f); } }
    __syncthreads();
    { const int m = wid >> 1;
#pragma unroll
      for (int nn = 0; nn < 2; ++nn) { const int n = (wid & 1) * 2 + nn;
          f32x4 a0 = {0.f, 0.f, 0.f, 0.f}, a1 = a0, a2 = a0;
          a0 = mm_lds_g(lds + R_TX, TS, m * 16, p.ws + WS_WDEC + (size_t)h * 64 * 128, 128, n * 16, 64, lane, a0);
          a1 = mm_lds_g(lds + R_XA, TS, m * 16, p.ws + WS_WICLR + (size_t)h * 64 * 128, 128, n * 16, 64, lane, a1);
          a2 = mm_lds_g(lds + R_SG, 272, m * 16, p.ws + WS_WGATE + (size_t)h * 64 * 256, 256, n * 16, 128, lane, a2);
          const int off = (m * 16 + (lane & 15)) * FS + (n * 16 + 4 * (lane >> 4)) * 4;
          *(LAS f32x4*)(lds + R_DL + off) = a0; *(LAS f32x4*)(lds + R_AL + off) = a1; *(LAS f32x4*)(lds + R_GG + off) = a2; } }
    __syncthreads();
    float av8[8], bv8[8];
    { float dl[8], al[8], gg[8];
      { const f32x4 x0 = *(const LAS f32x4*)(lds + R_DL + t * FS + jg * 32), x1 = *(const LAS f32x4*)(lds + R_DL + t * FS + jg * 32 + 16);
        const f32x4 y0 = *(const LAS f32x4*)(lds + R_AL + t * FS + jg * 32), y1 = *(const LAS f32x4*)(lds + R_AL + t * FS + jg * 32 + 16);
        const f32x4 z0 = *(const LAS f32x4*)(lds + R_GG + t * FS + jg * 32), z1 = *(const LAS f32x4*)(lds + R_GG + t * FS + jg * 32 + 16);
#pragma unroll
        for (int e = 0; e < 4; ++e) { dl[e] = x0[e]; dl[4 + e] = x1[e]; al[e] = y0[e]; al[4 + e] = y1[e]; gg[e] = z0[e]; gg[4 + e] = z1[e]; } }
      float w0v[8], a0v[8], kkv[8], kav[8], rkv[8];
      { const float4 q0 = *(const float4*)(p.w0 + hc), q1 = *(const float4*)(p.w0 + hc + 4); w0v[0] = q0.x; w0v[1] = q0.y; w0v[2] = q0.z; w0v[3] = q0.w; w0v[4] = q1.x; w0v[5] = q1.y; w0v[6] = q1.z; w0v[7] = q1.w; }
      { const float4 q0 = *(const float4*)(p.a0 + hc), q1 = *(const float4*)(p.a0 + hc + 4); a0v[0] = q0.x; a0v[1] = q0.y; a0v[2] = q0.z; a0v[3] = q0.w; a0v[4] = q1.x; a0v[5] = q1.y; a0v[6] = q1.z; a0v[7] = q1.w; }
      { const float4 q0 = *(const float4*)(p.k_k + hc), q1 = *(const float4*)(p.k_k + hc + 4); kkv[0] = q0.x; kkv[1] = q0.y; kkv[2] = q0.z; kkv[3] = q0.w; kkv[4] = q1.x; kkv[5] = q1.y; kkv[6] = q1.z; kkv[7] = q1.w; }
      { const float4 q0 = *(const float4*)(p.k_a + hc), q1 = *(const float4*)(p.k_a + hc + 4); kav[0] = q0.x; kav[1] = q0.y; kav[2] = q0.z; kav[3] = q0.w; kav[4] = q1.x; kav[5] = q1.y; kav[6] = q1.z; kav[7] = q1.w; }
      { const float4 q0 = *(const float4*)(p.r_k + hc), q1 = *(const float4*)(p.r_k + hc + 4); rkv[0] = q0.x; rkv[1] = q0.y; rkv[2] = q0.z; rkv[3] = q0.w; rkv[4] = q1.x; rkv[5] = q1.y; rkv[6] = q1.z; rkv[7] = q1.w; }
      float ld[8], aa[8], kk[8]; float ssq = 0.f;
#pragma unroll
      for (int e = 0; e < 8; ++e) {
          const float xx = w0v[e] + dl[e];
          const float sp = fmaxf(-xx, 0.f) + __logf(1.f + __expf(-fabsf(xx)));
          ld[e] = -__expf(-sp - 0.5f);
          aa[e] = __builtin_amdgcn_rcpf(1.f + __expf(-(a0v[e] + al[e])));
          kk[e] = k8[e] * kkv[e]; ssq += kk[e] * kk[e];
      }
      ssq += __shfl_xor(ssq, 1); ssq += __shfl_xor(ssq, 2); ssq += __shfl_xor(ssq, 4);
      const float kinv = __builtin_amdgcn_rsqf(fmaxf(ssq, 1e-24f));
      float bon = 0.f;
#pragma unroll
      for (int e = 0; e < 8; ++e) { kk[e] *= kinv; k8[e] = k8[e] * (1.f + (aa[e] - 1.f) * kav[e]); bon += r8[e] * k8[e] * rkv[e]; av8[e] = -kk[e]; bv8[e] = kk[e] * aa[e]; }
      bon += __shfl_xor(bon, 1); bon += __shfl_xor(bon, 2); bon += __shfl_xor(bon, 4);
      float bv[8];
#pragma unroll
      for (int e = 0; e < 8; ++e) bv[e] = bon * v8[e];
      const size_t go = (size_t)item * 4096 + t * 64 + jg * 8;
      *(u32x4*)((bf16_t*)(p.ws + WS_GATE) + go) = pack8(gg);
      *(u32x4*)((bf16_t*)(p.ws + WS_BONUS) + go) = pack8(bv);
      *(LAS f32x4*)(lds + R_DL + t * FS + jg * 32) = (f32x4){ld[0], ld[1], ld[2], ld[3]};
      *(LAS f32x4*)(lds + R_DL + t * FS + jg * 32 + 16) = (f32x4){ld[4], ld[5], ld[6], ld[7]};
    }
    __syncthreads();
    { const int j = tid & 63, seg = tid >> 6; float run = 0.f;
#pragma unroll
      for (int i = 0; i < 8; ++i) { LAS float* q = (LAS float*)(lds + R_DL + (seg * 8 + i) * FS + j * 4); run += *q; *q = run; }
      *(LAS float*)(lds + R_SEG + (seg * 64 + j) * 4) = run;
      __syncthreads();
      float pre = 0.f;
      for (int s2 = 0; s2 < seg; ++s2) pre += *(const LAS float*)(lds + R_SEG + (s2 * 64 + j) * 4);
#pragma unroll
      for (int i = 0; i < 8; ++i) { LAS float* q = (LAS float*)(lds + R_DL + (seg * 8 + i) * FS + j * 4); *q += pre; } }
    __syncthreads();
    { float L[8], Lp[8], LC[8];
      { const f32x4 x0 = *(const LAS f32x4*)(lds + R_DL + t * FS + jg * 32), x1 = *(const LAS f32x4*)(lds + R_DL + t * FS + jg * 32 + 16);
        const f32x4 c0 = *(const LAS f32x4*)(lds + R_DL + 63 * FS + jg * 32), c1 = *(const LAS f32x4*)(lds + R_DL + 63 * FS + jg * 32 + 16);
        f32x4 p0 = {0.f, 0.f, 0.f, 0.f}, p1 = p0;
        if (t > 0) { p0 = *(const LAS f32x4*)(lds + R_DL + (t - 1) * FS + jg * 32); p1 = *(const LAS f32x4*)(lds + R_DL + (t - 1) * FS + jg * 32 + 16); }
#pragma unroll
        for (int e = 0; e < 4; ++e) { L[e] = x0[e]; L[4 + e] = x1[e]; LC[e] = c0[e]; LC[4 + e] = c1[e]; Lp[e] = p0[e]; Lp[4 + e] = p1[e]; } }
      float at[8], bt[8], kt[8], rt[8];
#pragma unroll
      for (int e = 0; e < 8; ++e) {
          const float eL = __expf(L[e]), eLp = __expf(Lp[e]), einv = __expf(-L[e]), eC = __expf(LC[e] - L[e]);
          at[e] = av8[e] * eLp; bt[e] = bv8[e] * einv; kt[e] = k8[e] * einv; rt[e] = r8[e] * eL;
          const int ch = jg * 8 + e;
          *(LAS unsigned short*)(lds + R_VT + ch * TS + t * 2) = f2bf(v8[e]);
          *(LAS unsigned short*)(lds + R_BH + ch * TS + t * 2) = f2bf(bv8[e] * eC);
          *(LAS unsigned short*)(lds + R_KH + ch * TS + t * 2) = f2bf(k8[e] * eC);
          if (t == 63) ((float*)(p.ws + WS_GAM))[(size_t)item * 64 + ch] = __expf(LC[e]);
      }
      *(LAS f32x4*)(lds + R_RHS + t * RS + jg * 32) = (f32x4){at[0], at[1], at[2], at[3]};
      *(LAS f32x4*)(lds + R_RHS + t * RS + jg * 32 + 16) = (f32x4){at[4], at[5], at[6], at[7]};
      *(LAS u32x4*)(lds + R_AT + t * TS + jg * 16) = pack8(at);
      *(LAS u32x4*)(lds + R_BT + t * TS + jg * 16) = pack8(bt);
      *(LAS u32x4*)(lds + R_KT + t * TS + jg * 16) = pack8(kt);
      *(LAS u32x4*)(lds + R_RT + t * TS + jg * 16) = pack8(rt);
    }
    __syncthreads();
    { const int mat = wid >> 1;
      const LAS unsigned char* Aop = lds + ((mat < 2) ? R_AT : R_RT);
      const LAS unsigned char* Bop = lds + ((mat & 1) ? R_KT : R_BT);
      const int incl = (mat >= 2) ? 1 : 0;
#pragma unroll
      for (int mm = 0; mm < 2; ++mm) { const int m = (wid & 1) * 2 + mm;
#pragma unroll
          for (int n = 0; n < 4; ++n) {
              f32x4 acc = {0.f, 0.f, 0.f, 0.f};
              if (n <= m) acc = mm_lds(Aop, TS, m * 16, Bop, TS, n * 16, 64, lane, acc);
              const int tr = m * 16 + (lane & 15), s0 = n * 16 + 4 * (lane >> 4);
#pragma unroll
              for (int e = 0; e < 4; ++e) if (!(s0 + e < tr + incl)) acc[e] = 0.f;
              if (mat == 0) {
#pragma unroll
                  for (int e = 0; e < 4; ++e) *(LAS float*)(lds + R_AAB + (tr * 64 + e * 16 + n * 4 + (lane >> 4)) * 4) = acc[e];
              } else {
                  const int dst = (mat == 1) ? R_AAK : ((mat == 2) ? R_ARB : R_ARK);
                  *(LAS u32x2*)(lds + dst + tr * TS + s0 * 2) = (u32x2){cvt_pk_bf16(acc[0], acc[1]), cvt_pk_bf16(acc[2], acc[3])};
              }
          } } }
    __syncthreads();
    { const int m = wid >> 1;
#pragma unroll
      for (int nn = 0; nn < 2; ++nn) { const int n = (wid & 1) * 2 + nn;
          f32x4 acc = {0.f, 0.f, 0.f, 0.f};
          acc = mm_lds(lds + R_AAK, TS, m * 16, lds + R_VT, TS, n * 16, 64, lane, acc);
          *(LAS f32x4*)(lds + R_RHS + (m * 16 + (lane & 15)) * RS + (64 + n * 16 + 4 * (lane >> 4)) * 4) = acc; } }
    __syncthreads();
    { const int cc = lane >> 2, q = lane & 3, col = wid * 16 + cc;
      float ur[16];
#pragma unroll
      for (int i = 0; i < 16; ++i) ur[i] = *(const LAS float*)(lds + R_RHS + (4 * i + q) * RS + col * 4);
      const LAS unsigned char* abase = lds + R_AAB + q * 64;
      f32x4 ab[2][4];
      ab[1][0] = *(const LAS f32x4*)(abase + 1 * 256);
#pragma unroll
      for (int tt = 1; tt < 64; ++tt) {
          const int nI = (tt + 3) >> 2;
          if (tt < 63) { const int nJ = (tt + 4) >> 2;
#pragma unroll
              for (int i4 = 0; i4 < (nJ + 3) / 4; ++i4) ab[(tt + 1) & 1][i4] = *(const LAS f32x4*)(abase + (tt + 1) * 256 + i4 * 16); }
          float pa = 0.f, pb = 0.f;
#pragma unroll
          for (int i4 = 0; i4 < (nI + 3) / 4; ++i4) {
#pragma unroll
              for (int e = 0; e < 4; ++e) if (i4 * 4 + e < nI) { if (e & 1) pb += ab[tt & 1][i4][e] * ur[i4 * 4 + e]; else pa += ab[tt & 1][i4][e] * ur[i4 * 4 + e]; } }
          float pp = quad_sum(pa + pb);
          if (q == (tt & 3)) ur[tt >> 2] += pp;
      }
      const int dbase = (col < 64) ? (R_WT + col * TS) : (R_UT + (col - 64) * TS);
#pragma unroll
      for (int i = 0; i < 16; ++i) *(LAS unsigned short*)(lds + dbase + (4 * i + q) * 2) = f2bf(ur[i]);
    }
    __syncthreads();
    { const int o = wid >> 1;
      bf16_t* MPg = (bf16_t*)(p.ws + WS_MP) + (size_t)item * 4096; bf16_t* Pg = (bf16_t*)(p.ws + WS_P) + (size_t)item * 4096;
      float* Qg = p.out + (size_t)item * 4096; float* GTg = p.out + 8388608 + (size_t)item * 4096;
#pragma unroll
      for (int mm = 0; mm < 2; ++mm) { const int m = (wid & 1) * 2 + mm;
#pragma unroll
          for (int n = 0; n < 4; ++n) {
              f32x4 acc = {0.f, 0.f, 0.f, 0.f};
              const int rr = m * 16 + (lane & 15), c0 = n * 16 + 4 * (lane >> 4);
              if (o == 0) { acc = mm_lds(lds + R_BH, TS, m * 16, lds + R_WT, TS, n * 16, 64, lane, acc);
                  *(u32x2*)(MPg + rr * 64 + c0) = (u32x2){cvt_pk_bf16(acc[0], acc[1]), cvt_pk_bf16(acc[2], acc[3])}; }
              else if (o == 1) { acc = mm_lds(lds + R_UT, TS, m * 16, lds + R_BH, TS, n * 16, 64, lane, acc);
                  acc = mm_lds(lds + R_VT, TS, m * 16, lds + R_KH, TS, n * 16, 64, lane, acc);
                  *(f32x4*)(GTg + rr * 64 + c0) = acc; }
              else if (o == 2) { acc = mm_lds(lds + R_ARB, TS, m * 16, lds + R_WT, TS, n * 16, 64, lane, acc);
                  const u32x2 rv = *(const LAS u32x2*)(lds + R_RT + rr * TS + c0 * 2);
                  acc[0] += bf2f(rv[0] & 0xffffu); acc[1] += __uint_as_float(rv[0] & 0xffff0000u); acc[2] += bf2f(rv[1] & 0xffffu); acc[3] += __uint_as_float(rv[1] & 0xffff0000u);
                  *(u32x2*)(Pg + rr * 64 + c0) = (u32x2){cvt_pk_bf16(acc[0], acc[1]), cvt_pk_bf16(acc[2], acc[3])}; }
              else { acc = mm_lds(lds + R_ARB, TS, m * 16, lds + R_UT, TS, n * 16, 64, lane, acc);
                  acc = mm_lds(lds + R_ARK, TS, m * 16, lds + R_VT, TS, n * 16, 64, lane, acc);
                  *(f32x4*)(Qg + rr * 64 + c0) = acc; }
          } } }
    __syncthreads();
}

__device__ void phase_state(LAS unsigned char* lds, const Params& p) {
    const int tid = threadIdx.x, wid = tid >> 6, lane = tid & 63;
    const int bh = blockIdx.x >> 1, half = blockIdx.x & 1, b = bh >> 3, h = bh & 7;
    const int vl = wid >> 2, vb = half * 2 + vl, rb = wid & 3;
    const bf16_t* MP = (const bf16_t*)(p.ws + WS_MP); const float* GT = p.out + 8388608; const float* GAM = (const float*)(p.ws + WS_GAM);
    bf16_t* HST = (bf16_t*)(p.ws + WS_HST);
    const int arow = rb * 16 + (lane & 15), acol = 8 * (lane >> 4);
    const int irow = vb * 16 + (lane & 15), jcol = rb * 16 + 4 * (lane >> 4);
    f32x4 acc = {0.f, 0.f, 0.f, 0.f};
    const size_t item0 = (size_t)(b * 128) * 8 + h;
    constexpr int PD = 8;
    bf16x8 ra0[PD], ra1[PD]; f32x4 rgt[PD], rgm[PD];
#pragma unroll
    for (int u = 0; u < PD; ++u) { const size_t it = item0 + (size_t)u * 8;
        ra0[u] = *(const bf16x8*)(MP + it * 4096 + arow * 64 + acol); ra1[u] = *(const bf16x8*)(MP + it * 4096 + arow * 64 + acol + 32);
        rgt[u] = *(const f32x4*)(GT + it * 4096 + irow * 64 + jcol); rgm[u] = *(const f32x4*)(GAM + it * 64 + jcol); }
    int buf = 0;
    for (int c0 = 0; c0 < 128; c0 += PD) {
#pragma unroll
        for (int u = 0; u < PD; ++u) {
            const size_t item = item0 + (size_t)(c0 + u) * 8;
            const u32x2 pk = {cvt_pk_bf16(acc[0], acc[1]), cvt_pk_bf16(acc[2], acc[3])};
            *(LAS u32x2*)(lds + buf * 4608 + (vl * 16 + (lane & 15)) * TS + jcol * 2) = pk;
            *(u32x2*)(HST + item * 4096 + irow * 64 + jcol) = pk;
            const bf16x8 ca0 = ra0[u], ca1 = ra1[u]; const f32x4 cgt = rgt[u], cgm = rgm[u];
            if (c0 + PD < 128) { const size_t ni = item + (size_t)PD * 8;
                ra0[u] = *(const bf16x8*)(MP + ni * 4096 + arow * 64 + acol); ra1[u] = *(const bf16x8*)(MP + ni * 4096 + arow * 64 + acol + 32);
                rgt[u] = *(const f32x4*)(GT + ni * 4096 + irow * 64 + jcol); rgm[u] = *(const f32x4*)(GAM + ni * 64 + jcol); }
            __syncthreads();
            const bf16x8 b0 = *(const LAS bf16x8*)(lds + buf * 4608 + (vl * 16 + (lane & 15)) * TS + (lane >> 4) * 16);
            const bf16x8 b1 = *(const LAS bf16x8*)(lds + buf * 4608 + (vl * 16 + (lane & 15)) * TS + (lane >> 4) * 16 + 64);
            acc = cgm * acc + cgt;
            acc = __builtin_amdgcn_mfma_f32_16x16x32_bf16(ca0, b0, acc, 0, 0, 0);
            acc = __builtin_amdgcn_mfma_f32_16x16x32_bf16(ca1, b1, acc, 0, 0, 0);
            buf ^= 1;
        }
    }
}

__device__ void phase_out(const Params& p) {
    const int tid = threadIdx.x, wid = tid >> 6, lane = tid & 63, sub = wid >> 2, mt = wid & 3;
    const bf16_t* Pm = (const bf16_t*)(p.ws + WS_P); const bf16_t* HST = (const bf16_t*)(p.ws + WS_HST); const float* Q = p.out;
    const bf16_t* GA = (const bf16_t*)(p.ws + WS_GATE); const bf16_t* BO = (const bf16_t*)(p.ws + WS_BONUS); bf16_t* mix = (bf16_t*)(p.ws + WS_MIX);
    for (int u = (int)blockIdx.x; u < 1024; u += (int)gridDim.x) {
        const size_t item = (size_t)u * 2 + sub; const int h = (int)(item & 7), c = (int)((item >> 3) & 127), b = (int)(item >> 10);
        const int tr = mt * 16 + (lane & 15);
        const bf16x8 a0 = *(const bf16x8*)(Pm + item * 4096 + tr * 64 + 8 * (lane >> 4)), a1 = *(const bf16x8*)(Pm + item * 4096 + tr * 64 + 8 * (lane >> 4) + 32);
        f32x4 y[4]; float s = 0.f;
#pragma unroll
        for (int n = 0; n < 4; ++n) {
            const bf16_t* hp = HST + item * 4096 + (n * 16 + (lane & 15)) * 64 + 8 * (lane >> 4);
            const bf16x8 b0 = *(const bf16x8*)hp, b1 = *(const bf16x8*)(hp + 32);
            f32x4 acc = *(const f32x4*)(Q + item * 4096 + tr * 64 + n * 16 + 4 * (lane >> 4));
            acc = __builtin_amdgcn_mfma_f32_16x16x32_bf16(b0, a0, acc, 0, 0, 0);
            acc = __builtin_amdgcn_mfma_f32_16x16x32_bf16(b1, a1, acc, 0, 0, 0);
            y[n] = acc; s += acc[0] + acc[1] + acc[2] + acc[3];
        }
        s += __shfl_xor(s, 16); s += __shfl_xor(s, 32);
        const float mu = s * (1.f / 64.f); float vs = 0.f;
#pragma unroll
        for (int n = 0; n < 4; ++n)
#pragma unroll
            for (int e = 0; e < 4; ++e) { const float d = y[n][e] - mu; vs += d * d; }
        vs += __shfl_xor(vs, 16); vs += __shfl_xor(vs, 32);
        const float rstd = rsqrtf(vs * (1.f / 64.f) + 64e-5f);
        const size_t orow = (size_t)(b * SEQ + c * 64 + tr) * DM + 512 + h * 64;
#pragma unroll
        for (int n = 0; n < 4; ++n) { const int i0 = n * 16 + 4 * (lane >> 4);
            const float4 lw = *(const float4*)(p.lnx_w + h * 64 + i0), lb = *(const float4*)(p.lnx_b + h * 64 + i0);
            const u32x2 gv = *(const u32x2*)(GA + item * 4096 + tr * 64 + i0), bv = *(const u32x2*)(BO + item * 4096 + tr * 64 + i0);
            const float g0 = bf2f(gv[0] & 0xffffu), g1 = __uint_as_float(gv[0] & 0xffff0000u), g2 = bf2f(gv[1] & 0xffffu), g3 = __uint_as_float(gv[1] & 0xffff0000u);
            const float o0 = bf2f(bv[0] & 0xffffu), o1 = __uint_as_float(bv[0] & 0xffff0000u), o2 = bf2f(bv[1] & 0xffffu), o3 = __uint_as_float(bv[1] & 0xffff0000u);
            const float r0 = ((y[n][0] - mu) * rstd * lw.x + lb.x + o0) * g0, r1 = ((y[n][1] - mu) * rstd * lw.y + lb.y + o1) * g1,
                        r2 = ((y[n][2] - mu) * rstd * lw.z + lb.z + o2) * g2, r3 = ((y[n][3] - mu) * rstd * lw.w + lb.w + o3) * g3;
            *(u32x2*)(mix + orow + i0) = (u32x2){cvt_pk_bf16(r0, r1), cvt_pk_bf16(r2, r3)}; }
    }
}


#ifndef DIAG
#define DIAG 0
#endif
__device__ void dump_bf16(const bf16_t* src, int ld, int coff, float* out) {
    for (size_t i = (size_t)blockIdx.x * 512 + threadIdx.x; i < (size_t)MTOK * DM; i += (size_t)gridDim.x * 512) {
        const size_t r = i >> 10, c = i & 1023; float v = bf2f(src[r * ld + coff + c]); if (!(v == v) || fabsf(v) > 1e30f) v = 7777.f; out[i] = v; }
}
__global__ void __launch_bounds__(512, 2) fwd_megakernel(Params p) {
    extern __shared__ __attribute__((aligned(16))) unsigned char shm[];
    LAS unsigned char* lds = (LAS unsigned char*)shm;
    cg::grid_group grid = cg::this_grid();
    if (p.ws == nullptr) grid.sync();
    if (threadIdx.x < 4) *(volatile LAS unsigned*)(lds + LDS_ST + threadIdx.x * 4) = 0u;
    __syncthreads();
    const XcdBarrier xbar = xcd_barrier_post((unsigned*)(p.ws + WS_BAR), (volatile LAS unsigned*)(lds + LDS_ST));
#define GSYNC() xcd_barrier(xbar)
    float* mod = (float*)(p.ws + WS_MOD);
    phase0(lds, p);
    GSYNC();
    phase_norm(p.x, p.norm1_g, mod, 0, 1024, (bf16_t*)(p.ws + WS_H));
    GSYNC();
    { EpiZ e; e.O = (bf16_t*)(p.ws + WS_Z); e.ldc = INC; run_gemm(lds, (const bf16_t*)(p.ws + WS_H), (const bf16_t*)(p.ws + WS_WIN), INC, 1024, e); }
    if (blockIdx.x >= 64) conv_run((LAS float*)lds, p, 624 + (int)blockIdx.x - 64, (int)gridDim.x - 64, 2992);
    GSYNC();
    if (DIAG == 2) { dump_bf16((const bf16_t*)(p.ws + WS_Z), INC, 0, p.out); return; }
    if (DIAG == 3) { dump_bf16((const bf16_t*)(p.ws + WS_Z), INC, 1024, p.out); return; }
    for (int it = (int)blockIdx.x; it < 2048; it += (int)gridDim.x) scan_pre_item(lds, p, it);
    GSYNC();
    if (blockIdx.x < 32) phase_state(lds, p);
    else for (int it = (int)blockIdx.x - 32; it < 1024; it += (int)gridDim.x - 32) pool_item(lds, p, it >> 2, it & 3);
    GSYNC();
    phase_out(p);
    GSYNC();
    if (DIAG == 5) { dump_bf16((const bf16_t*)(p.ws + WS_MIX), DM, 0, p.out); return; }
    { EpiRes e; e.xin = p.x; e.out = p.out; e.gate = mod + 2048; run_gemm(lds, (const bf16_t*)(p.ws + WS_MIX), (const bf16_t*)(p.ws + WS_WOUT), 1024, 1024, e); }
    GSYNC();
    phase_norm(p.out, p.norm2_g, mod, 3072, 4096, (bf16_t*)(p.ws + WS_H));
    GSYNC();
    { EpiAct e; e.O = (bf16_t*)(p.ws + WS_ACT); run_gemm(lds, (const bf16_t*)(p.ws + WS_H), (const bf16_t*)(p.ws + WS_WGU), 2 * DFF, 1024, e); }
    GSYNC();
    { EpiRes e; e.xin = p.out; e.out = p.out; e.gate = mod + 5120; run_gemm(lds, (const bf16_t*)(p.ws + WS_ACT), (const bf16_t*)(p.ws + WS_WDN), 1024, DFF, e); }
    GSYNC();
    phase_final(p.out, p.final_g);
}

extern "C" void kernel_launch(void* const* d_in, const int* in_sizes, int n_in, void* d_out, int out_size, void* d_ws, size_t ws_size, hipStream_t stream) {
    static int grid_blocks = 0;
    if (!grid_blocks) {
        int dev = 0, cus = 0, per_cu = 0;
        hipGetDevice(&dev);
        hipDeviceGetAttribute(&cus, hipDeviceAttributeMultiprocessorCount, dev);
        hipFuncSetAttribute((const void*)fwd_megakernel, hipFuncAttributeMaxDynamicSharedMemorySize, LDS_BYTES);
        hipOccupancyMaxActiveBlocksPerMultiprocessor(&per_cu, (const void*)fwd_megakernel, 512, LDS_BYTES);
        if (per_cu < 1) { fprintf(stderr, "occupancy query says %d blocks/CU\n", per_cu); per_cu = 1; }
        grid_blocks = cus * 1;
        (void)hipGetLastError();
    }
    Params p{};
    const float** f = (const float**)&p;
    for (int i = 0; i < 24; ++i) f[i] = (const float*)d_in[i];
    p.out = (float*)d_out; p.ws = (unsigned char*)d_ws;
    (void)hipMemsetAsync((unsigned char*)d_ws + WS_BAR, 0, XCD_BAR_WORDS * sizeof(unsigned), stream);
    (void)hipMemsetAsync((unsigned char*)d_ws + WS_MOD, 0, 2 * 6144 * sizeof(float), stream);
    void* args[] = {&p};
    hipError_t e = hipLaunchCooperativeKernel((const void*)fwd_megakernel, dim3(grid_blocks), dim3(512), args, LDS_BYTES, stream);
    if (e != hipSuccess) fprintf(stderr, "cooperative launch failed: %s (grid %d)\n", hipGetErrorString(e), grid_blocks);
}
```

```cpp
#include <hip/hip_runtime.h>
#include <hip/hip_cooperative_groups.h>
#include <cstdio>
namespace cg = cooperative_groups;
namespace pg8 {
#define PG8_LAS __attribute__((address_space(3)))
typedef unsigned short bf16_t;
typedef short bf16x8 __attribute__((ext_vector_type(8)));
typedef float f32x4 __attribute__((ext_vector_type(4)));
typedef unsigned u32x4 __attribute__((ext_vector_type(4)));
constexpr int BM = 256, BK = 64, HALF = 128, HTB = HALF * BK * 2  , STAGE_BYTES = 8 * HTB, NXCD = 8, WGM = 8;

__host__ __device__ __forceinline__ int lds_byte(int r, int c) { const int st = (r >> 4) * 2 + (c >> 5), rr = r & 15, cc = c & 31, ob = rr * 64 + cc * 2; return st * 1024 + (ob ^ (((ob >> 9) & 1) << 5)); }
__host__ __device__ __forceinline__ void stage_rc(int b, int& R, int& C) { const int st = b / 1024, sb = b % 1024, swz = sb ^ (((sb >> 9) & 1) << 5); R = (st >> 1) * 16 + swz / 64; C = (st & 1) * 32 + (swz % 64) / 2; }
__host__ __device__ __forceinline__ int perm32(int rho) { const int n = rho >> 4, i = rho & 15; return 8 * (i >> 2) + 4 * n + (i & 3); }

struct Unit { int pm, pn; };
struct Gemm { const bf16_t* A; const bf16_t* Bt; int M, N, K; };

struct StaticOrder {
    int nM, nN, nwg, G, c;
    __host__ __device__ void init(int M, int N, int G_, int c_) { nM = M / BM; nN = N / BM; nwg = nM * nN; G = G_; c = c_; }
    __host__ __device__ bool next(int i, Unit& u) const {
        const long L = (long)i * G + c; if (L >= nwg) return false;
        int wgid = (int)L; { const int q = nwg / NXCD, r = nwg % NXCD, xcd = wgid % NXCD, off = wgid / NXCD; wgid = (xcd < r ? xcd * (q + 1) : r * (q + 1) + (xcd - r) * q) + off; }
        const int nig = WGM * nN, gid = wgid / nig, fm = gid * WGM, gsz = (nM - fm) < WGM ? (nM - fm) : WGM;
        u.pm = fm + ((wgid % nig) % gsz); u.pn = (wgid % nig) / gsz; return true;
    }
    __device__ __forceinline__ void a_ready(const Unit&) const {}
    __device__ __forceinline__ void done(const Unit&) const {}
};
typedef float f32x2_t __attribute__((ext_vector_type(2)));
typedef __bf16 bf16x2_t __attribute__((ext_vector_type(2)));
__device__ __forceinline__ unsigned cvt_pk_bf16(float lo, float hi) { const f32x2_t v = {lo, hi}; const bf16x2_t r = __builtin_convertvector(v, bf16x2_t); return __builtin_bit_cast(unsigned, r); }

template <class Epi, class Sched, bool STAMP = false>
__device__ __forceinline__ void gemm_phase(PG8_LAS unsigned char* lds, const Gemm g, const Sched& S, const Epi& E, unsigned long long* stamps) {
    const int tid = threadIdx.x, wid = __builtin_amdgcn_readfirstlane(tid >> 6), lane = tid & 63, wr = wid >> 2, wc = wid & 3, fr = lane & 15, fq = lane >> 4;
    const int K = g.K, nt = K / BK;
    int ts_lo = 0, ts_hi = 0, nts = 0; const unsigned long long rt_entry = STAMP ? (unsigned long long)wall_clock64() : 0ull;
#define PG8_STAMP() do { if (STAMP && wid == 0 && nts < 64) { const unsigned long long _c = (unsigned long long)clock64(); \
        ts_lo = (lane == nts) ? (int)(unsigned)_c : ts_lo; ts_hi = (lane == nts) ? (int)(unsigned)(_c >> 32) : ts_hi; ++nts; } } while (0)
    PG8_STAMP();
    unsigned voffA[2], voffB[2];
#pragma unroll
    for (int i = 0; i < 2; ++i) { int R, C; stage_rc(tid * 16 + i * 8192, R, C); const int Rb = Epi::PERM ? ((R & ~31) + perm32(R & 31)) : R;
        voffA[i] = (unsigned)(R * K + C) * 2u; voffB[i] = (unsigned)(Rb * K + C) * 2u; }
    const size_t kstep = (size_t)(BK * 2);
    const size_t hstep = (size_t)HALF * K * 2;
    const size_t tstep = 2 * hstep;
    const unsigned ldsw = (unsigned)wid * 1024u;
    const int aoff = lds_byte(wr * 64 + fr, fq * 8), boff = lds_byte(wc * 32 + fr, fq * 8);
#define PG8_SA(b, h) (((b) * 2 + (h)) * HTB)
#define PG8_SB(b, h) ((4 + (b) * 2 + (h)) * HTB)
#define PG8_STAGE(bufoff, gbase, voff) do { _Pragma("unroll") for (int _i = 0; _i < 2; ++_i) \
        __builtin_amdgcn_global_load_lds((const unsigned*)((const char*)(gbase) + (voff)[_i]), (PG8_LAS unsigned*)(lds + (bufoff) + ldsw + _i * 8192), 16, 0, 0); } while (0)
#define PG8_LDA(dst, b, h) do { _Pragma("unroll") for (int m = 0; m < 4; ++m) _Pragma("unroll") for (int k = 0; k < 2; ++k) dst[m][k] = *(const PG8_LAS bf16x8*)(lds + PG8_SA(b, h) + aoff + m * 2048 + k * 1024); } while (0)
#define PG8_LDB(dst, b, h) do { _Pragma("unroll") for (int n = 0; n < 2; ++n) _Pragma("unroll") for (int k = 0; k < 2; ++k) dst[n][k] = *(const PG8_LAS bf16x8*)(lds + PG8_SB(b, h) + boff + n * 2048 + k * 1024); } while (0)
#define PG8_MMA(ai, bj, At, Bt) do { __builtin_amdgcn_s_setprio(1); _Pragma("unroll") for (int m = 0; m < 4; ++m) _Pragma("unroll") for (int n = 0; n < 2; ++n) _Pragma("unroll") for (int k = 0; k < 2; ++k) \
        acc[ai][bj][m][n] = __builtin_amdgcn_mfma_f32_16x16x32_bf16(Bt[n][k], At[m][k], acc[ai][bj][m][n], 0, 0, 0); __builtin_amdgcn_s_setprio(0); } while (0)
#define PG8_WAIT_V(n) asm volatile("s_waitcnt vmcnt(" #n ")" ::: "memory")
#define PG8_WAIT_L(n) asm volatile("s_waitcnt lgkmcnt(" #n ")" ::: "memory")
#define PG8_BAR __builtin_amdgcn_s_barrier()
#define PG8_SCHED __builtin_amdgcn_sched_barrier(0)
    Unit cur, nxt; int ui = 0;
    if (!S.next(0, cur)) return;
    f32x4 acc[2][2][4][2];
#pragma unroll
    for (int a = 0; a < 2; ++a)
#pragma unroll
        for (int b = 0; b < 2; ++b)
#pragma unroll
            for (int m = 0; m < 4; ++m)
#pragma unroll
                for (int n = 0; n < 2; ++n) acc[a][b][m][n] = (f32x4){0.f, 0.f, 0.f, 0.f};
    bf16x8 At[4][2], B0[2][2], B1[2][2];
    const char* cA = (const char*)g.A + (size_t)cur.pm * tstep; const char* cB = (const char*)g.Bt + (size_t)cur.pn * tstep;
    S.a_ready(cur);
    PG8_STAGE(PG8_SB(0, 0), cB, voffB); PG8_STAGE(PG8_SA(0, 0), cA, voffA); PG8_STAGE(PG8_SB(0, 1), cB + hstep, voffB); PG8_STAGE(PG8_SA(0, 1), cA + hstep, voffA);
    if (wr == 1) PG8_BAR;
    PG8_WAIT_V(4); PG8_BAR;
    PG8_STAGE(PG8_SB(1, 0), cB + kstep, voffB); PG8_STAGE(PG8_SA(1, 0), cA + kstep, voffA); PG8_STAGE(PG8_SB(1, 1), cB + hstep + kstep, voffB);
    PG8_WAIT_V(6); PG8_BAR;
    PG8_STAMP();
    for (;;) {
        const bool has_next = S.next(ui + 1, nxt);
        const char* nA = has_next ? (const char*)g.A + (size_t)nxt.pm * tstep : cA; const char* nB = has_next ? (const char*)g.Bt + (size_t)nxt.pn * tstep : cB;
        for (int t = 0; t < nt; t += 2) {
            const bool last = (t == nt - 2);
            const char* a1 = cA + (size_t)(t + 1) * kstep;
            const char* a2 = last ? nA : cA + (size_t)(t + 2) * kstep; const char* b2 = last ? nB : cB + (size_t)(t + 2) * kstep;
            const char* a3 = a2 + kstep; const char* b3 = b2 + kstep;
            if (last && has_next) S.a_ready(nxt);
            PG8_LDB(B0, 0, 0); PG8_SCHED; PG8_LDA(At, 0, 0); PG8_STAGE(PG8_SA(1, 1), a1 + hstep, voffA);
            PG8_WAIT_L(8); PG8_BAR; PG8_WAIT_L(0); PG8_MMA(0, 0, At, B0); PG8_BAR; PG8_SCHED;
            PG8_LDB(B1, 0, 1); PG8_STAGE(PG8_SB(0, 0), b2, voffB);
            PG8_BAR; PG8_WAIT_L(0); PG8_MMA(0, 1, At, B1); PG8_BAR;
            PG8_LDA(At, 0, 1); PG8_STAGE(PG8_SA(0, 0), a2, voffA);
            PG8_BAR; PG8_WAIT_L(0); PG8_MMA(1, 0, At, B0); PG8_BAR; PG8_SCHED;
            PG8_STAGE(PG8_SB(0, 1), b2 + hstep, voffB);
            PG8_WAIT_V(6); PG8_BAR; PG8_MMA(1, 1, At, B1); PG8_BAR;
            PG8_LDB(B0, 1, 0); PG8_SCHED; PG8_LDA(At, 1, 0); PG8_STAGE(PG8_SA(0, 1), a2 + hstep, voffA);
            PG8_WAIT_L(8); PG8_BAR; PG8_WAIT_L(0); PG8_MMA(0, 0, At, B0); PG8_BAR; PG8_SCHED;
            PG8_LDB(B1, 1, 1); PG8_STAGE(PG8_SB(1, 0), b3, voffB);
            PG8_BAR; PG8_WAIT_L(0); PG8_MMA(0, 1, At, B1); PG8_BAR;
            PG8_LDA(At, 1, 1); PG8_STAGE(PG8_SA(1, 0), a3, voffA);
            PG8_BAR; PG8_WAIT_L(0); PG8_MMA(1, 0, At, B0); PG8_BAR; PG8_SCHED;
            PG8_STAGE(PG8_SB(1, 1), b3 + hstep, voffB);
            PG8_WAIT_V(6); PG8_BAR; PG8_MMA(1, 1, At, B1); PG8_BAR;
        }
        PG8_STAMP();
        if constexpr (!Epi::AFTER_DRAIN) { E(acc, cur, wr, wc, fr, fq); S.done(cur); }
        PG8_STAMP();
        if (!has_next) break;
#pragma unroll
        for (int a = 0; a < 2; ++a)
#pragma unroll
            for (int b = 0; b < 2; ++b)
#pragma unroll
                for (int m = 0; m < 4; ++m)
#pragma unroll
                    for (int n = 0; n < 2; ++n) acc[a][b][m][n] = (f32x4){0.f, 0.f, 0.f, 0.f};
        cur = nxt; cA = nA; cB = nB; ++ui;
    }
    PG8_WAIT_V(0);
    if (wr == 0) PG8_BAR;
    PG8_BAR;
    if constexpr (Epi::AFTER_DRAIN) { E.fused(acc, cur, wr, wc, fr, fq, lds, wid, lane); S.done(cur); }
    PG8_STAMP();
    if (STAMP && wid == 0) { stamps[lane] = lane < nts ? (((unsigned long long)(unsigned)ts_hi << 32) | (unsigned)ts_lo) : 0ull;
        if (lane == 62) stamps[62] = rt_entry; if (lane == 63) stamps[63] = (unsigned long long)wall_clock64(); }
#undef PG8_STAMP
#undef PG8_SA
#undef PG8_SB
#undef PG8_STAGE
#undef PG8_LDA
#undef PG8_LDB
#undef PG8_MMA
#undef PG8_WAIT_V
#undef PG8_WAIT_L
#undef PG8_BAR
#undef PG8_SCHED
}
}

using pg8::bf16_t; using pg8::bf16x8; using pg8::f32x4; using pg8::u32x4; using pg8::cvt_pk_bf16;
#define LAS __attribute__((address_space(3)))
typedef unsigned u32x2 __attribute__((ext_vector_type(2)));

constexpr int MTOK = 16384, DM = 1024, INC = 2304, DFF = 2816, SEQ = 8192;
constexpr size_t MiB = 1ull << 20;
constexpr size_t WS_WIN = 0, WS_WOUT = 4718592, WS_WGU = 6815744, WS_WDN = 18350080, WS_WPOOL = 24117248, WS_WDEC = 24248320,
                 WS_WICLR = 24313856, WS_WGATE = 24379392, WS_MOD = 24510464, WS_GAM = 24559616,
                 WS_H = 24 * MiB, WS_MP = 24 * MiB, WS_P = 40 * MiB, WS_Z = 56 * MiB, WS_ACT = 56 * MiB, WS_GATE = 128 * MiB,
                 WS_BONUS = 144 * MiB, WS_HST = 160 * MiB, WS_MIX = 176 * MiB;
constexpr int LDS_ST = 143360;
constexpr int LDS_BYTES = 143376;
constexpr size_t WS_BAR = 208 * MiB;
constexpr int TS = 144;
constexpr int R_AT = 0, R_BT = 9216, R_KT = 18432, R_RT = 27648, R_VT = 36864, R_BH = 46080, R_KH = 55296, R_AAK = 64512, R_ARB = 73728, R_ARK = 82944,
              R_AAB = 92160, R_RHS = 108544;
constexpr int R_TX = R_AT, R_XA = R_BT, R_SG = R_KT  , R_WT = R_AT, R_UT = R_BT;
constexpr int R_DL = R_AAK  , R_SEG = R_ARK, R_AL = R_RHS, R_GG = R_RHS + 17408;
constexpr int FS = 272;
constexpr int RS = 544;

struct Params {
    const float *x, *c, *ada_w, *ada_b, *norm1_g, *w_in, *mu_shift, *pool_w, *pool_scale, *w0, *w_decay_up, *a0, *w_iclr_up, *w_gate_up,
                *k_k, *k_a, *r_k, *lnx_w, *lnx_b, *w_out, *norm2_g, *w_ffn_gu, *w_ffn_down, *final_g;
    float* out; unsigned char* ws;
};

__device__ __forceinline__ float bf2f(unsigned v) { return __uint_as_float(v << 16); }
__device__ __forceinline__ float wave_sum(float v) {
#pragma unroll
    for (int o = 32; o > 0; o >>= 1) v += __shfl_xor(v, o);
    return v;
}
__device__ __forceinline__ float quad_sum(float v) {
    int t = __builtin_amdgcn_update_dpp(0, __float_as_int(v), 0xB1, 0xF, 0xF, true); v += __int_as_float(t);
    t = __builtin_amdgcn_update_dpp(0, __float_as_int(v), 0x4E, 0xF, 0xF, true); v += __int_as_float(t);
    return v;
}
__device__ __forceinline__ void unpack8(u32x4 v, float (&f)[8]) {
#pragma unroll
    for (int i = 0; i < 4; ++i) { f[2 * i] = __uint_as_float(v[i] << 16); f[2 * i + 1] = __uint_as_float(v[i] & 0xffff0000u); }
}
__device__ __forceinline__ u32x4 pack8(const float (&f)[8]) { return (u32x4){cvt_pk_bf16(f[0], f[1]), cvt_pk_bf16(f[2], f[3]), cvt_pk_bf16(f[4], f[5]), cvt_pk_bf16(f[6], f[7])}; }
__device__ __forceinline__ unsigned short f2bf(float f) { return (unsigned short)(cvt_pk_bf16(f, 0.f) & 0xffffu); }

__device__ __forceinline__ f32x4 mm_lds(const LAS unsigned char* A, int sa, int m0, const LAS unsigned char* Bt, int sb, int n0, int K, int lane, f32x4 acc) {
    const LAS unsigned char* ap = A + (m0 + (lane & 15)) * sa + (lane >> 4) * 16;
    const LAS unsigned char* bp = Bt + (n0 + (lane & 15)) * sb + (lane >> 4) * 16;
#pragma unroll
    for (int k0 = 0; k0 < K; k0 += 32) {
        const bf16x8 a = *(const LAS bf16x8*)(ap + k0 * 2), b = *(const LAS bf16x8*)(bp + k0 * 2);
        acc = __builtin_amdgcn_mfma_f32_16x16x32_bf16(b, a, acc, 0, 0, 0);
    }
    return acc;
}
__device__ __forceinline__ f32x4 mm_lds_g(const LAS unsigned char* A, int sa, int m0, const unsigned char* Bt, int sb, int n0, int K, int lane, f32x4 acc) {
    const LAS unsigned char* ap = A + (m0 + (lane & 15)) * sa + (lane >> 4) * 16;
    const unsigned char* bp = Bt + (size_t)(n0 + (lane & 15)) * sb + (lane >> 4) * 16;
#pragma unroll
    for (int k0 = 0; k0 < K; k0 += 32) {
        const bf16x8 a = *(const LAS bf16x8*)(ap + k0 * 2), b = *(const bf16x8*)(bp + k0 * 2);
        acc = __builtin_amdgcn_mfma_f32_16x16x32_bf16(b, a, acc, 0, 0, 0);
    }
    return acc;
}

#define XB_TMO      128
#define XB_XCNT(j)  (256  + 64 * (j))
#define XB_XSUB(j)  (1280 + 64 * (j))
#define XB_XGEN(j)  (2304 + 64 * (j))
#define XB_TOP      3328
#define XB_TOPGEN   3392
#define XCD_BAR_WORDS 3456
#define XB_SPIN_CAP (1u << 18)

__device__ __forceinline__ unsigned xb_ld(unsigned* p)              { return __hip_atomic_load(p, __ATOMIC_RELAXED, __HIP_MEMORY_SCOPE_AGENT); }
__device__ __forceinline__ unsigned xb_add(unsigned* p, unsigned v) { return __hip_atomic_fetch_add(p, v, __ATOMIC_RELAXED, __HIP_MEMORY_SCOPE_AGENT); }
__device__ __forceinline__ unsigned xb_xcc_id() { return (unsigned)__builtin_amdgcn_s_getreg((3 << 11) | 20) & 0xFu; }
#define XB_SPIN(cond, bar) do { unsigned _sp = 0; while (cond) { __builtin_amdgcn_s_sleep(1); \
    if ((++_sp & 255u) == 0u) { if (xb_ld(&(bar)[XB_TMO])) break; if (_sp > XB_SPIN_CAP) { atomicAdd(&(bar)[XB_TMO], 1u); break; } } } } while (0)

struct XcdBarrier {
    unsigned* bar; unsigned x;
    volatile LAS unsigned* st;
};

__device__ __forceinline__ XcdBarrier xcd_barrier_post(unsigned* bar, volatile LAS unsigned* st) {
    XcdBarrier b; b.bar = bar; b.x = xb_xcc_id(); b.st = st;
    if (threadIdx.x == 0) (void)xb_add(&bar[XB_XCNT(b.x)], 1u);
    return b;
}
__device__ __forceinline__ void xcd_barrier_complete(unsigned* bar, unsigned x, unsigned& nloc, unsigned& nx) {
    const unsigned G = gridDim.x * gridDim.y * gridDim.z;
    unsigned sum, cnt, mine, sp = 0u;
    for (;;) {
        sum = 0u; cnt = 0u; mine = 0u;
#pragma unroll
        for (unsigned j = 0; j < 16; ++j) { const unsigned c = xb_ld(&bar[XB_XCNT(j)]); sum += c; cnt += (c > 0u) ? 1u : 0u; mine = (j == x) ? c : mine; }
        if (sum == G) break;
        __builtin_amdgcn_s_sleep(1);
        if ((++sp & 255u) == 0u) { if (xb_ld(&bar[XB_TMO])) break; if (sp > XB_SPIN_CAP) { atomicAdd(&bar[XB_TMO], 1u); break; } }
    }
    nloc = mine > 0u ? mine : 1u; nx = cnt > 0u ? cnt : 1u;
}

__device__ __forceinline__ void xcd_barrier(const XcdBarrier& b) {
    asm volatile("s_waitcnt vmcnt(0)" ::: "memory");
    __syncthreads();
    if (threadIdx.x == 0) {
        unsigned* bar = b.bar;
        __builtin_amdgcn_s_waitcnt(0);
        unsigned nloc = b.st[0], nx = b.st[1];
        if (nloc == 0u) { xcd_barrier_complete(bar, b.x, nloc, nx); b.st[0] = nloc; b.st[1] = nx; }
        const unsigned old = xb_add(&bar[XB_XSUB(b.x)], 1u);
        const unsigned gen = old / nloc;
        if (old + 1u == (gen + 1u) * nloc) {
            __builtin_amdgcn_fence(__ATOMIC_RELEASE, "agent");
            asm volatile("s_waitcnt vmcnt(0)" ::: "memory");
            const unsigned og = xb_add(&bar[XB_TOP], 1u);
            const unsigned tg = og / nx;
            if (og + 1u == (tg + 1u) * nx) xb_add(&bar[XB_TOPGEN], 1u);
            else XB_SPIN(xb_ld(&bar[XB_TOPGEN]) == tg, bar);
            __builtin_amdgcn_fence(__ATOMIC_ACQUIRE, "agent");
            xb_add(&bar[XB_XGEN(b.x)], 1u);
            asm volatile("s_waitcnt vmcnt(0)" ::: "memory");
        } else {
            XB_SPIN(xb_ld(&bar[XB_XGEN(b.x)]) == gen, bar);
            __builtin_amdgcn_fence(__ATOMIC_ACQUIRE, "agent");
            asm volatile("s_waitcnt vmcnt(0)" ::: "memory");
        }
    }
    __syncthreads();
}

struct ConvJob { const float* src; bf16_t* dst; int K, N, mode, kt, nt; };
__device__ __forceinline__ ConvJob conv_job(const Params& p, int t) {
    ConvJob j; j.mode = 0; int loc;
    if (t < 576) { loc = t; j.src = p.w_in; j.dst = (bf16_t*)(p.ws + WS_WIN); j.K = 1024; j.N = INC; }
    else if (t < 592) { const int g = (t - 576) >> 2; loc = (t - 576) & 3; j.src = p.pool_w + g * 16384; j.dst = (bf16_t*)(p.ws + WS_WPOOL) + g * 16384; j.K = 128; j.N = 128; }
    else if (t < 600) { loc = t - 592; j.src = p.w_decay_up; j.dst = (bf16_t*)(p.ws + WS_WDEC); j.K = 64; j.N = 512; }
    else if (t < 608) { loc = t - 600; j.src = p.w_iclr_up; j.dst = (bf16_t*)(p.ws + WS_WICLR); j.K = 64; j.N = 512; }
    else if (t < 624) { loc = t - 608; j.src = p.w_gate_up; j.dst = (bf16_t*)(p.ws + WS_WGATE); j.K = 128; j.N = 512; }
    else if (t < 880) { loc = t - 624; j.src = p.w_out; j.dst = (bf16_t*)(p.ws + WS_WOUT); j.K = 1024; j.N = 1024; }
    else if (t < 2288) { loc = t - 880; j.src = p.w_ffn_gu; j.dst = (bf16_t*)(p.ws + WS_WGU); j.K = 1024; j.N = 2 * DFF; j.mode = 1; }
    else { loc = t - 2288; j.src = p.w_ffn_down; j.dst = (bf16_t*)(p.ws + WS_WDN); j.K = DFF; j.N = 1024; }
    const int ntn = j.N / 64; j.kt = loc / ntn; j.nt = loc % ntn; return j;
}
__device__ void conv_run(LAS float* tile, const Params& p, int first, int stride, int hi) {
    const int tid = threadIdx.x, r = tid >> 4, c4 = (tid & 15) * 4, n = tid >> 3, k8 = (tid & 7) * 8;
    if (first >= hi) return;
    ConvJob j = conv_job(p, first);
    float4 v0 = *(const float4*)(j.src + (size_t)(j.kt * 64 + r) * j.N + j.nt * 64 + c4), v1 = *(const float4*)(j.src + (size_t)(j.kt * 64 + r + 32) * j.N + j.nt * 64 + c4);
    for (int t = first; t < hi; t += stride) {
        tile[r * 65 + c4 + 0] = v0.x; tile[r * 65 + c4 + 1] = v0.y; tile[r * 65 + c4 + 2] = v0.z; tile[r * 65 + c4 + 3] = v0.w;
        tile[(r + 32) * 65 + c4 + 0] = v1.x; tile[(r + 32) * 65 + c4 + 1] = v1.y; tile[(r + 32) * 65 + c4 + 2] = v1.z; tile[(r + 32) * 65 + c4 + 3] = v1.w;
        __syncthreads();
        const ConvJob cj = j;
        if (t + stride < hi) { j = conv_job(p, t + stride);
            v0 = *(const float4*)(j.src + (size_t)(j.kt * 64 + r) * j.N + j.nt * 64 + c4); v1 = *(const float4*)(j.src + (size_t)(j.kt * 64 + r + 32) * j.N + j.nt * 64 + c4); }
        float f[8];
#pragma unroll
        for (int e = 0; e < 8; ++e) f[e] = tile[(k8 + e) * 65 + n];
        const int col = cj.nt * 64 + n; int drow = col;
        if (cj.mode == 1) drow = col < DFF ? (col / 128) * 256 + (col % 128) : ((col - DFF) / 128) * 256 + 128 + ((col - DFF) % 128);
        *(u32x4*)(cj.dst + (size_t)drow * cj.K + cj.kt * 64 + k8) = pack8(f);
        __syncthreads();
    }
}
__device__ __forceinline__ void mod_unit(LAS float* red, const Params& p, int u) {
    const int tid = threadIdx.x, w = tid >> 6, lane = tid & 63, cu = u >> 1, kh = u & 1, n = cu * 64 + lane;
    float a0 = 0.f, a1 = 0.f;
    const int kb = kh * 512 + w * 64;
#pragma unroll 16
    for (int k = kb; k < kb + 64; ++k) {
        const float wv = p.ada_w[(size_t)k * 6144 + n]; const float c0 = p.c[k], c1 = p.c[1024 + k];
        a0 += (c0 / (1.f + __expf(-c0))) * wv; a1 += (c1 / (1.f + __expf(-c1))) * wv;
    }
    red[(w * 2 + 0) * 64 + lane] = a0; red[(w * 2 + 1) * 64 + lane] = a1;
    __syncthreads();
    if (tid < 128) { const int b = tid >> 6; float s = 0.f;
#pragma unroll
        for (int w2 = 0; w2 < 8; ++w2) s += red[(w2 * 2 + b) * 64 + lane];
        if (kh == 0) s += p.ada_b[n];
        atomicAdd((float*)(p.ws + WS_MOD) + b * 6144 + n, s); }
    __syncthreads();
}
__device__ void phase0(LAS unsigned char* lds, const Params& p) {
    if (blockIdx.x < 192) mod_unit((LAS float*)lds, p, blockIdx.x);
    conv_run((LAS float*)lds, p, (int)blockIdx.x, (int)gridDim.x, 624);
}

__device__ void phase_norm(const float* X, const float* g, const float* mod, int sh_off, int sc_off, bf16_t* H) {
    const int wid = threadIdx.x >> 6, lane = threadIdx.x & 63;
    const int nw = (int)gridDim.x * 8, gw = (int)blockIdx.x * 8 + wid;
#pragma unroll 1
    for (int b = 0; b < 2; ++b) {
        const float* mb = mod + b * 6144;
        float4 ga[4], sa[4];
#pragma unroll
        for (int j = 0; j < 4; ++j) { const int col = (j * 64 + lane) * 4;
            const float4 gg = *(const float4*)(g + col), sc = *(const float4*)(mb + sc_off + col); sa[j] = *(const float4*)(mb + sh_off + col);
            ga[j] = make_float4(gg.x * (1.f + sc.x), gg.y * (1.f + sc.y), gg.z * (1.f + sc.z), gg.w * (1.f + sc.w)); }
        int row = b * SEQ + gw;
        float4 v[4];
        if (row < (b + 1) * SEQ) {
#pragma unroll
            for (int j = 0; j < 4; ++j) v[j] = *(const float4*)(X + (size_t)row * DM + (j * 64 + lane) * 4); }
        for (; row < (b + 1) * SEQ; row += nw) {
            float4 c[4];
#pragma unroll
            for (int j = 0; j < 4; ++j) c[j] = v[j];
            if (row + nw < (b + 1) * SEQ) {
#pragma unroll
                for (int j = 0; j < 4; ++j) v[j] = *(const float4*)(X + (size_t)(row + nw) * DM + (j * 64 + lane) * 4); }
            float ss = 0.f;
#pragma unroll
            for (int j = 0; j < 4; ++j) ss += c[j].x * c[j].x + c[j].y * c[j].y + c[j].z * c[j].z + c[j].w * c[j].w;
            ss = wave_sum(ss); const float rstd = rsqrtf(ss * (1.f / 1024.f) + 1e-6f);
#pragma unroll
            for (int j = 0; j < 4; ++j) { const int col = (j * 64 + lane) * 4;
                const float h0 = (c[j].x * rstd) * ga[j].x + sa[j].x, h1 = (c[j].y * rstd) * ga[j].y + sa[j].y, h2 = (c[j].z * rstd) * ga[j].z + sa[j].z, h3 = (c[j].w * rstd) * ga[j].w + sa[j].w;
                *(u32x2*)(H + (size_t)row * DM + col) = (u32x2){cvt_pk_bf16(h0, h1), cvt_pk_bf16(h2, h3)}; }
        }
    }
}
__device__ void phase_final(float* X, const float* g) {
    const int wid = threadIdx.x >> 6, lane = threadIdx.x & 63;
    const int nw = (int)gridDim.x * 8, gw = (int)blockIdx.x * 8 + wid;
    float4 ga[4];
#pragma unroll
    for (int j = 0; j < 4; ++j) ga[j] = *(const float4*)(g + (j * 64 + lane) * 4);
    int row = gw;
    float4 v[4];
    if (row < MTOK) {
#pragma unroll
        for (int j = 0; j < 4; ++j) v[j] = *(const float4*)(X + (size_t)row * DM + (j * 64 + lane) * 4); }
    for (; row < MTOK; row += nw) {
        float4 c[4];
#pragma unroll
        for (int j = 0; j < 4; ++j) c[j] = v[j];
        if (row + nw < MTOK) {
#pragma unroll
            for (int j = 0; j < 4; ++j) v[j] = *(const float4*)(X + (size_t)(row + nw) * DM + (j * 64 + lane) * 4); }
        float ss = 0.f;
#pragma unroll
        for (int j = 0; j < 4; ++j) ss += c[j].x * c[j].x + c[j].y * c[j].y + c[j].z * c[j].z + c[j].w * c[j].w;
        ss = wave_sum(ss); const float rstd = rsqrtf(ss * (1.f / 1024.f) + 1e-6f);
#pragma unroll
        for (int j = 0; j < 4; ++j) { const int col = (j * 64 + lane) * 4;
            *(float4*)(X + (size_t)row * DM + col) = make_float4(c[j].x * rstd * ga[j].x, c[j].y * rstd * ga[j].y, c[j].z * rstd * ga[j].z, c[j].w * rstd * ga[j].w); }
    }
}

struct EpiZ {
    static constexpr bool PERM = true, AFTER_DRAIN = false;
    bf16_t* O; int ldc;
    __device__ __forceinline__ void operator()(const f32x4 (&acc)[2][2][4][2], const pg8::Unit& u, int wr, int wc, int fr, int fq) const {
        const int row0 = u.pm * 256 + wr * 64 + fr, col0 = u.pn * 256 + wc * 32 + 8 * fq;
#pragma unroll
        for (int ai = 0; ai < 2; ++ai)
#pragma unroll
            for (int m = 0; m < 4; ++m) { bf16_t* rowp = O + (size_t)(row0 + ai * 128 + m * 16) * ldc + col0;
#pragma unroll
                for (int bj = 0; bj < 2; ++bj) { const f32x4 v0 = acc[ai][bj][m][0], v1 = acc[ai][bj][m][1];
                    *(u32x4*)(rowp + bj * 128) = (u32x4){cvt_pk_bf16(v0[0], v0[1]), cvt_pk_bf16(v0[2], v0[3]), cvt_pk_bf16(v1[0], v1[1]), cvt_pk_bf16(v1[2], v1[3])}; } }
    }
};
struct EpiRes {
    static constexpr bool PERM = false, AFTER_DRAIN = false;
    const float* xin; float* out; const float* gate;
    __device__ __forceinline__ void operator()(const f32x4 (&acc)[2][2][4][2], const pg8::Unit& u, int wr, int wc, int fr, int fq) const {
        const int row0 = u.pm * 256 + wr * 64 + fr, col0 = u.pn * 256 + wc * 32 + 4 * fq;
        const float* gb = gate + (u.pm >> 5) * 6144;
        f32x4 gv[2][2];
#pragma unroll
        for (int bj = 0; bj < 2; ++bj)
#pragma unroll
            for (int n = 0; n < 2; ++n) gv[bj][n] = *(const f32x4*)(gb + col0 + bj * 128 + n * 16);
#pragma unroll
        for (int ai = 0; ai < 2; ++ai)
#pragma unroll
            for (int m = 0; m < 4; ++m) { const size_t ro = (size_t)(row0 + ai * 128 + m * 16) * DM + col0;
#pragma unroll
                for (int bj = 0; bj < 2; ++bj)
#pragma unroll
                    for (int n = 0; n < 2; ++n) { const f32x4 xv = *(const f32x4*)(xin + ro + bj * 128 + n * 16);
                        *(f32x4*)(out + ro + bj * 128 + n * 16) = xv + gv[bj][n] * acc[ai][bj][m][n]; } }
    }
};
struct EpiAct {
    static constexpr bool PERM = true, AFTER_DRAIN = false;
    bf16_t* O;
    __device__ __forceinline__ void operator()(const f32x4 (&acc)[2][2][4][2], const pg8::Unit& u, int wr, int wc, int fr, int fq) const {
        const int row0 = u.pm * 256 + wr * 64 + fr, col0 = u.pn * 128 + wc * 32 + 8 * fq;
#pragma unroll
        for (int ai = 0; ai < 2; ++ai)
#pragma unroll
            for (int m = 0; m < 4; ++m) { float r[8];
#pragma unroll
                for (int n = 0; n < 2; ++n)
#pragma unroll
                    for (int e = 0; e < 4; ++e) { const float gt = acc[ai][0][m][n][e], up = acc[ai][1][m][n][e]; r[n * 4 + e] = gt * __builtin_amdgcn_rcpf(1.f + __expf(-gt)) * up; }
                *(u32x4*)(O + (size_t)(row0 + ai * 128 + m * 16) * DFF + col0) = pack8(r); }
    }
};
template <class Epi> __device__ __forceinline__ void run_gemm(LAS unsigned char* lds, const bf16_t* A, const bf16_t* Bt, int N, int K, const Epi& E) {
    pg8::Gemm g; g.A = A; g.Bt = Bt; g.M = MTOK; g.N = N; g.K = K;
    pg8::StaticOrder S; S.init(MTOK, N, (int)gridDim.x, (int)blockIdx.x);
    pg8::gemm_phase<Epi, pg8::StaticOrder, false>(lds, g, S, E, nullptr);
}

__device__ void pool_item(LAS unsigned char* lds, const Params& p, int tt, int g) {
    const int tid = threadIdx.x, t = tid >> 3, cgp = tid & 7, wid = tid >> 6, lane = tid & 63;
    const bf16_t* Z = (const bf16_t*)(p.ws + WS_Z);
    const int row0 = tt * 64, tl0 = row0 & (SEQ - 1), w = 2 << g;
    constexpr int UOFF = 0, DOFF = 24576;
#pragma unroll
    for (int i = 0; i < 3; ++i) { const int pc = tid + i * 512;
        if (pc < 79 * 16) { const int r = pc >> 4, c16 = pc & 15; const int tl = tl0 - 15 + r;
            u32x4 v = {0u, 0u, 0u, 0u};
            if (tl >= 0) v = *(const u32x4*)(Z + (size_t)(row0 - 15 + r) * INC + g * 128 + c16 * 8);
            *(LAS u32x4*)(lds + UOFF + r * 272 + c16 * 16) = v; } }
    __syncthreads();
    { const int tl = tl0 + t, cnt = (tl + 1) < w ? (tl + 1) : w; const float inv = 1.f / (float)cnt;
      float s0[8], s1[8], u0[8], u1[8];
      const LAS unsigned char* up = lds + UOFF + (t + 15) * 272 + cgp * 32;
      unpack8(*(const LAS u32x4*)up, u0); unpack8(*(const LAS u32x4*)(up + 16), u1);
#pragma unroll
      for (int e = 0; e < 8; ++e) { s0[e] = u0[e]; s1[e] = u1[e]; }
      for (int q = 1; q < w; ++q) { float a[8], b[8]; unpack8(*(const LAS u32x4*)(up - q * 272), a); unpack8(*(const LAS u32x4*)(up - q * 272 + 16), b);
#pragma unroll
          for (int e = 0; e < 8; ++e) { s0[e] += a[e]; s1[e] += b[e]; } }
#pragma unroll
      for (int e = 0; e < 8; ++e) { s0[e] = s0[e] * inv - u0[e]; s1[e] = s1[e] * inv - u1[e]; }
      *(LAS u32x4*)(lds + DOFF + t * 272 + cgp * 32) = pack8(s0); *(LAS u32x4*)(lds + DOFF + t * 272 + cgp * 32 + 16) = pack8(s1); }
    __syncthreads();
    const unsigned char* Bt = p.ws + WS_WPOOL + (size_t)g * 32768;
    const float4 ps = *(const float4*)(p.pool_scale + g * 128 + wid * 16 + 4 * (lane >> 4));
    bf16_t* mix = (bf16_t*)(p.ws + WS_MIX);
#pragma unroll
    for (int m = 0; m < 4; ++m) {
        f32x4 acc = {0.f, 0.f, 0.f, 0.f};
        acc = mm_lds_g(lds + DOFF, 272, m * 16, Bt, 256, wid * 16, 128, lane, acc);
        const int orow = tt * 64 + m * 16 + (lane & 15), ocol = g * 128 + wid * 16 + 4 * (lane >> 4);
        *(u32x2*)(mix + (size_t)orow * DM + ocol) = (u32x2){cvt_pk_bf16(acc[0] * ps.x, acc[1] * ps.y), cvt_pk_bf16(acc[2] * ps.z, acc[3] * ps.w)};
    }
    __syncthreads();
}

__device__ __forceinline__ void shifted8(const bf16_t* Z, int row, bool has_prev, int col, const float* mu_shift, float (&o)[8]) {
    float cur[8], prv[8];
    unpack8(*(const u32x4*)(Z + (size_t)row * INC + col), cur);
    if (has_prev) unpack8(*(const u32x4*)(Z + (size_t)(row - 1) * INC + col), prv);
    else {
#pragma unroll
        for (int e = 0; e < 8; ++e) prv[e] = 0.f; }
    const float4 m0 = *(const float4*)(mu_shift + col - 512), m1 = *(const float4*)(mu_shift + col - 512 + 4);
    const float mu[8] = {m0.x, m0.y, m0.z, m0.w, m1.x, m1.y, m1.z, m1.w};
#pragma unroll
    for (int e = 0; e < 8; ++e) o[e] = cur[e] + (prv[e] - cur[e]) * mu[e];
}
__device__ void scan_pre_item(LAS unsigned char* lds, const Params& p, int item) {
    const int tid = threadIdx.x, t = tid >> 3, jg = tid & 7, wid = __builtin_amdgcn_readfirstlane(tid >> 6), lane = tid & 63;
    const int h = item & 7, c = (item >> 3) & 127, b = item >> 10;
    const bf16_t* Z = (const bf16_t*)(p.ws + WS_Z);
    const int row = b * SEQ + c * 64 + t; const bool has_prev = (c * 64 + t) > 0;
    const int hc = h * 64 + jg * 8;
    float r8[8], k8[8], v8[8];
    shifted8(Z, row, has_prev, 512 + hc, p.mu_shift, r8);
    shifted8(Z, row, has_prev, 1024 + hc, p.mu_shift, k8);
    shifted8(Z, row, has_prev, 1536 + hc, p.mu_shift, v8);
    { float f[8];
      shifted8(Z, row, has_prev, 2048 + jg * 8, p.mu_shift, f);
#pragma unroll
      for (int e = 0; e < 8; ++e) f[e] = 1.f - 2.f * __builtin_amdgcn_rcpf(__expf(2.f * f[e]) + 1.f);
      *(LAS u32x4*)(lds + R_TX + t * TS + jg * 16) = pack8(f);
      shifted8(Z, row, has_prev, 2112 + jg * 8, p.mu_shift, f);
      *(LAS u32x4*)(lds + R_XA + t * TS + jg * 16) = pack8(f);
#pragma unroll
      for (int hh = 0; hh < 2; ++hh) { shifted8(Z, row, has_prev, 2176 + jg * 16 + hh * 8, p.mu_shift, f);
#pragma unroll
          for (int e = 0; e < 8; ++e) f[e] = __builtin_amdgcn_rcpf(1.f + __expf(-f[e]));
          *(LAS u32x4*)(lds + R_SG + t * 272 + jg * 32 + hh * 16) = pack8(f); } }
    __syncthreads();
    { const int m = wid >> 1;
#pragma unroll
      for (int nn = 0; nn < 2; ++nn) { const int n = (wid & 1) * 2 + nn;
          f32x4 a0 = {0.f, 0.f, 0.f, 0.f}, a1 = a0, a2 = a0;
          a0 = mm_lds_g(lds + R_TX, TS, m * 16, p.ws + WS_WDEC + (size_t)h * 64 * 128, 128, n * 16, 64, lane, a0);
          a1 = mm_lds_g(lds + R_XA, TS, m * 16, p.ws + WS_WICLR + (size_t)h * 64 * 128, 128, n * 16, 64, lane, a1);
          a2 = mm_lds_g(lds + R_SG, 272, m * 16, p.ws + WS_WGATE + (size_t)h * 64 * 256, 256, n * 16, 128, lane, a2);
          const int off = (m * 16 + (lane & 15)) * FS + (n * 16 + 4 * (lane >> 4)) * 4;
          *(LAS f32x4*)(lds + R_DL + off) = a0; *(LAS f32x4*)(lds + R_AL + off) = a1; *(LAS f32x4*)(lds + R_GG + off) = a2; } }
    __syncthreads();
    float av8[8], bv8[8];
    { float dl[8], al[8], gg[8];
      { const f32x4 x0 = *(const LAS f32x4*)(lds + R_DL + t * FS + jg * 32), x1 = *(const LAS f32x4*)(lds + R_DL + t * FS + jg * 32 + 16);
        const f32x4 y0 = *(const LAS f32x4*)(lds + R_AL + t * FS + jg * 32), y1 = *(const LAS f32x4*)(lds + R_AL + t * FS + jg * 32 + 16);
        const f32x4 z0 = *(const LAS f32x4*)(lds + R_GG + t * FS + jg * 32), z1 = *(const LAS f32x4*)(lds + R_GG + t * FS + jg * 32 + 16);
#pragma unroll
        for (int e = 0; e < 4; ++e) { dl[e] = x0[e]; dl[4 + e] = x1[e]; al[e] = y0[e]; al[4 + e] = y1[e]; gg[e] = z0[e]; gg[4 + e] = z1[e]; } }
      float w0v[8], a0v[8], kkv[8], kav[8], rkv[8];
      { const float4 q0 = *(const float4*)(p.w0 + hc), q1 = *(const float4*)(p.w0 + hc + 4); w0v[0] = q0.x; w0v[1] = q0.y; w0v[2] = q0.z; w0v[3] = q0.w; w0v[4] = q1.x; w0v[5] = q1.y; w0v[6] = q1.z; w0v[7] = q1.w; }
      { const float4 q0 = *(const float4*)(p.a0 + hc), q1 = *(const float4*)(p.a0 + hc + 4); a0v[0] = q0.x; a0v[1] = q0.y; a0v[2] = q0.z; a0v[3] = q0.w; a0v[4] = q1.x; a0v[5] = q1.y; a0v[6] = q1.z; a0v[7] = q1.w; }
      { const float4 q0 = *(const float4*)(p.k_k + hc), q1 = *(const float4*)(p.k_k + hc + 4); kkv[0] = q0.x; kkv[1] = q0.y; kkv[2] = q0.z; kkv[3] = q0.w; kkv[4] = q1.x; kkv[5] = q1.y; kkv[6] = q1.z; kkv[7] = q1.w; }
      { const float4 q0 = *(const float4*)(p.k_a + hc), q1 = *(const float4*)(p.k_a + hc + 4); kav[0] = q0.x; kav[1] = q0.y; kav[2] = q0.z; kav[3] = q0.w; kav[4] = q1.x; kav[5] = q1.y; kav[6] = q1.z; kav[7] = q1.w; }
      { const float4 q0 = *(const float4*)(p.r_k + hc), q1 = *(const float4*)(p.r_k + hc + 4); rkv[0] = q0.x; rkv[1] = q0.y; rkv[2] = q0.z; rkv[3] = q0.w; rkv[4] = q1.x; rkv[5] = q1.y; rkv[6] = q1.z; rkv[7] = q1.w; }
      float ld[8], aa[8], kk[8]; float ssq = 0.f;
#pragma unroll
      for (int e = 0; e < 8; ++e) {
          const float xx = w0v[e] + dl[e];
          const float sp = fmaxf(-xx, 0.f) + __logf(1.f + __expf(-fabsf(xx)));
          ld[e] = -__expf(-sp - 0.5f);
          aa[e] = __builtin_amdgcn_rcpf(1.f + __expf(-(a0v[e] + al[e])));
          kk[e] = k8[e] * kkv[e]; ssq += kk[e] * kk[e];
      }
      ssq += __shfl_xor(ssq, 1); ssq += __shfl_xor(ssq, 2); ssq += __shfl_xor(ssq, 4);
      const float kinv = __builtin_amdgcn_rsqf(fmaxf(ssq, 1e-24f));
      float bon = 0.f;
#pragma unroll
      for (int e = 0; e < 8; ++e) { kk[e] *= kinv; k8[e] = k8[e] * (1.f + (aa[e] - 1.f) * kav[e]); bon += r8[e] * k8[e] * rkv[e]; av8[e] = -kk[e]; bv8[e] = kk[e] * aa[e]; }
      bon += __shfl_xor(bon, 1); bon += __shfl_xor(bon, 2); bon += __shfl_xor(bon, 4);
      float bv[8];
#pragma unroll
      for (int e = 0; e < 8; ++e) bv[e] = bon * v8[e];
      const size_t go = (size_t)item * 4096 + t * 64 + jg * 8;
      *(u32x4*)((bf16_t*)(p.ws + WS_GATE) + go) = pack8(gg);
      *(u32x4*)((bf16_t*)(p.ws + WS_BONUS) + go) = pack8(bv);
      *(LAS f32x4*)(lds + R_DL + t * FS + jg * 32) = (f32x4){ld[0], ld[1], ld[2], ld[3]};
      *(LAS f32x4*)(lds + R_DL + t * FS + jg * 32 + 16) = (f32x4){ld[4], ld[5], ld[6], ld[7]};
    }
    __syncthreads();
    { const int j = tid & 63, seg = tid >> 6; float run = 0.f;
#pragma unroll
      for (int i = 0; i < 8; ++i) { LAS float* q = (LAS float*)(lds + R_DL + (seg * 8 + i) * FS + j * 4); run += *q; *q = run; }
      *(LAS float*)(lds + R_SEG + (seg * 64 + j) * 4) = run;
      __syncthreads();
      float pre = 0.f;
      for (int s2 = 0; s2 < seg; ++s2) pre += *(const LAS float*)(lds + R_SEG + (s2 * 64 + j) * 4);
#pragma unroll
      for (int i = 0; i < 8; ++i) { LAS float* q = (LAS float*)(lds + R_DL + (seg * 8 + i) * FS + j * 4); *q += pre; } }
    __syncthreads();
    { float L[8], Lp[8], LC[8];
      { const f32x4 x0 = *(const LAS f32x4*)(lds + R_DL + t * FS + jg * 32), x1 = *(const LAS f32x4*)(lds + R_DL + t * FS + jg * 32 + 16);
        const f32x4 c0 = *(const LAS f32x4*)(lds + R_DL + 63 * FS + jg * 32), c1 = *(const LAS f32x4*)(lds + R_DL + 63 * FS + jg * 32 + 16);
        f32x4 p0 = {0.f, 0.f, 0.f, 0.f}, p1 = p0;
        if (t > 0) { p0 = *(const LAS f32x4*)(lds + R_DL + (t - 1) * FS + jg * 32); p1 = *(const LAS f32x4*)(lds + R_DL + (t - 1) * FS + jg * 32 + 16); }
#pragma unroll
        for (int e = 0; e < 4; ++e) { L[e] = x0[e]; L[4 + e] = x1[e]; LC[e] = c0[e]; LC[4 + e] = c1[e]; Lp[e] = p0[e]; Lp[4 + e] = p1[e]; } }
      float at[8], bt[8], kt[8], rt[8];
#pragma unroll
      for (int e = 0; e < 8; ++e) {
          const float eL = __expf(L[e]), eLp = __expf(Lp[e]), einv = __expf(-L[e]), eC = __expf(LC[e] - L[e]);
          at[e] = av8[e] * eLp; bt[e] = bv8[e] * einv; kt[e] = k8[e] * einv; rt[e] = r8[e] * eL;
          const int ch = jg * 8 + e;
          *(LAS unsigned short*)(lds + R_VT + ch * TS + t * 2) = f2bf(v8[e]);
          *(LAS unsigned short*)(lds + R_BH + ch * TS + t * 2) = f2bf(bv8[e] * eC);
          *(LAS unsigned short*)(lds + R_KH + ch * TS + t * 2) = f2bf(k8[e] * eC);
          if (t == 63) ((float*)(p.ws + WS_GAM))[(size_t)item * 64 + ch] = __expf(LC[e]);
      }
      *(LAS f32x4*)(lds + R_RHS + t * RS + jg * 32) = (f32x4){at[0], at[1], at[2], at[3]};
      *(LAS f32x4*)(lds + R_RHS + t * RS + jg * 32 + 16) = (f32x4){at[4], at[5], at[6], at[7]};
      *(LAS u32x4*)(lds + R_AT + t * TS + jg * 16) = pack8(at);
      *(LAS u32x4*)(lds + R_BT + t * TS + jg * 16) = pack8(bt);
      *(LAS u32x4*)(lds + R_KT + t * TS + jg * 16) = pack8(kt);
      *(LAS u32x4*)(lds + R_RT + t * TS + jg * 16) = pack8(rt);
    }
    __syncthreads();
    { const int mat = wid >> 1;
      const LAS unsigned char* Aop = lds + ((mat < 2) ? R_AT : R_RT);
      const LAS unsigned char* Bop = lds + ((mat & 1) ? R_KT : R_BT);
      const int incl = (mat >= 2) ? 1 : 0;
#pragma unroll
      for (int mm = 0; mm < 2; ++mm) { const int m = (wid & 1) ? (mm ? 2 : 1) : (mm ? 3 : 0);
#pragma unroll
          for (int n = 0; n < 4; ++n) {
              f32x4 acc = {0.f, 0.f, 0.f, 0.f};
              if (n <= m) acc = mm_lds(Aop, TS, m * 16, Bop, TS, n * 16, 64, lane, acc);
              const int tr = m * 16 + (lane & 15), s0 = n * 16 + 4 * (lane >> 4);
#pragma unroll
              for (int e = 0; e < 4; ++e) if (!(s0 + e < tr + incl)) acc[e] = 0.f;
              if (mat == 0) {
#pragma unroll
                  for (int e = 0; e < 4; ++e) *(LAS float*)(lds + R_AAB + (tr * 64 + e * 16 + n * 4 + (lane >> 4)) * 4) = acc[e];
              } else {
                  const int dst = (mat == 1) ? R_AAK : ((mat == 2) ? R_ARB : R_ARK);
                  *(LAS u32x2*)(lds + dst + tr * TS + s0 * 2) = (u32x2){cvt_pk_bf16(acc[0], acc[1]), cvt_pk_bf16(acc[2], acc[3])};
              }
          } } }
    __syncthreads();
    { const int m = wid >> 1;
#pragma unroll
      for (int nn = 0; nn < 2; ++nn) { const int n = (wid & 1) * 2 + nn;
          f32x4 acc = {0.f, 0.f, 0.f, 0.f};
          acc = mm_lds(lds + R_AAK, TS, m * 16, lds + R_VT, TS, n * 16, 64, lane, acc);
          *(LAS f32x4*)(lds + R_RHS + (m * 16 + (lane & 15)) * RS + (64 + n * 16 + 4 * (lane >> 4)) * 4) = acc; } }
    __syncthreads();
    { const int cc = lane >> 2, q = lane & 3, col = wid * 16 + cc;
      float ur[16];
#pragma unroll
      for (int i = 0; i < 16; ++i) ur[i] = *(const LAS float*)(lds + R_RHS + (4 * i + q) * RS + col * 4);
      const LAS unsigned char* abase = lds + R_AAB + q * 64;
      f32x4 ab[2][4];
      ab[1][0] = *(const LAS f32x4*)(abase + 1 * 256);
#pragma unroll
      for (int tt = 1; tt < 64; ++tt) {
          const int nI = (tt + 3) >> 2;
          if (tt < 63) { const int nJ = (tt + 4) >> 2;
#pragma unroll
              for (int i4 = 0; i4 < (nJ + 3) / 4; ++i4) ab[(tt + 1) & 1][i4] = *(const LAS f32x4*)(abase + (tt + 1) * 256 + i4 * 16); }
          float pa = 0.f, pb = 0.f;
#pragma unroll
          for (int i4 = 0; i4 < (nI + 3) / 4; ++i4) {
#pragma unroll
              for (int e = 0; e < 4; ++e) if (i4 * 4 + e < nI) { if (e & 1) pb += ab[tt & 1][i4][e] * ur[i4 * 4 + e]; else pa += ab[tt & 1][i4][e] * ur[i4 * 4 + e]; } }
          float pp = quad_sum(pa + pb);
          if (q == (tt & 3)) ur[tt >> 2] += pp;
      }
      const int dbase = (col < 64) ? (R_WT + col * TS) : (R_UT + (col - 64) * TS);
#pragma unroll
      for (int i = 0; i < 16; ++i) *(LAS unsigned short*)(lds + dbase + (4 * i + q) * 2) = f2bf(ur[i]);
    }
    __syncthreads();
    { bf16_t* MPg = (bf16_t*)(p.ws + WS_MP) + (size_t)item * 4096; bf16_t* Pg = (bf16_t*)(p.ws + WS_P) + (size_t)item * 4096;
      float* Qg = p.out + (size_t)item * 4096; float* GTg = p.out + 8388608 + (size_t)item * 4096;
#pragma unroll
      for (int oo = 0; oo < 2; ++oo) { const int o = (wid >> 2) * 2 + oo, m = wid & 3;
#pragma unroll
          for (int n = 0; n < 4; ++n) {
              f32x4 acc = {0.f, 0.f, 0.f, 0.f};
              const int rr = m * 16 + (lane & 15), c0 = n * 16 + 4 * (lane >> 4);
              if (o == 0) { acc = mm_lds(lds + R_BH, TS, m * 16, lds + R_WT, TS, n * 16, 64, lane, acc);
                  *(u32x2*)(MPg + rr * 64 + c0) = (u32x2){cvt_pk_bf16(acc[0], acc[1]), cvt_pk_bf16(acc[2], acc[3])}; }
              else if (o == 1) { acc = mm_lds(lds + R_UT, TS, m * 16, lds + R_BH, TS, n * 16, 64, lane, acc);
                  acc = mm_lds(lds + R_VT, TS, m * 16, lds + R_KH, TS, n * 16, 64, lane, acc);
                  *(f32x4*)(GTg + rr * 64 + c0) = acc; }
              else if (o == 2) { acc = mm_lds(lds + R_ARB, TS, m * 16, lds + R_WT, TS, n * 16, 64, lane, acc);
                  const u32x2 rv = *(const LAS u32x2*)(lds + R_RT + rr * TS + c0 * 2);
                  acc[0] += bf2f(rv[0] & 0xffffu); acc[1] += __uint_as_float(rv[0] & 0xffff0000u); acc[2] += bf2f(rv[1] & 0xffffu); acc[3] += __uint_as_float(rv[1] & 0xffff0000u);
                  *(u32x2*)(Pg + rr * 64 + c0) = (u32x2){cvt_pk_bf16(acc[0], acc[1]), cvt_pk_bf16(acc[2], acc[3])}; }
              else { acc = mm_lds(lds + R_ARB, TS, m * 16, lds + R_UT, TS, n * 16, 64, lane, acc);
                  acc = mm_lds(lds + R_ARK, TS, m * 16, lds + R_VT, TS, n * 16, 64, lane, acc);
                  *(f32x4*)(Qg + rr * 64 + c0) = acc; }
          } } }
    __syncthreads();
}

__device__ void phase_state(LAS unsigned char* lds, const Params& p) {
    const int tid = threadIdx.x, wid = tid >> 6, lane = tid & 63;
    const int bh = blockIdx.x >> 1, half = blockIdx.x & 1, b = bh >> 3, h = bh & 7;
    const int vl = wid >> 2, vb = half * 2 + vl, rb = wid & 3;
    const bf16_t* MP = (const bf16_t*)(p.ws + WS_MP); const float* GT = p.out + 8388608; const float* GAM = (const float*)(p.ws + WS_GAM);
    bf16_t* HST = (bf16_t*)(p.ws + WS_HST);
    const int arow = rb * 16 + (lane & 15), acol = 8 * (lane >> 4);
    const int irow = vb * 16 + (lane & 15), jcol = rb * 16 + 4 * (lane >> 4);
    f32x4 acc = {0.f, 0.f, 0.f, 0.f};
    const size_t item0 = (size_t)(b * 128) * 8 + h;
    constexpr int PD = 8;
    bf16x8 ra0[PD], ra1[PD]; f32x4 rgt[PD], rgm[PD];
#pragma unroll
    for (int u = 0; u < PD; ++u) { const size_t it = item0 + (size_t)u * 8;
        ra0[u] = *(const bf16x8*)(MP + it * 4096 + arow * 64 + acol); ra1[u] = *(const bf16x8*)(MP + it * 4096 + arow * 64 + acol + 32);
        rgt[u] = *(const f32x4*)(GT + it * 4096 + irow * 64 + jcol); rgm[u] = *(const f32x4*)(GAM + it * 64 + jcol); }
    int buf = 0;
    for (int c0 = 0; c0 < 128; c0 += PD) {
#pragma unroll
        for (int u = 0; u < PD; ++u) {
            const size_t item = item0 + (size_t)(c0 + u) * 8;
            const u32x2 pk = {cvt_pk_bf16(acc[0], acc[1]), cvt_pk_bf16(acc[2], acc[3])};
            *(LAS u32x2*)(lds + buf * 4608 + (vl * 16 + (lane & 15)) * TS + jcol * 2) = pk;
            *(u32x2*)(HST + item * 4096 + irow * 64 + jcol) = pk;
            const bf16x8 ca0 = ra0[u], ca1 = ra1[u]; const f32x4 cgt = rgt[u], cgm = rgm[u];
            if (c0 + PD < 128) { const size_t ni = item + (size_t)PD * 8;
                ra0[u] = *(const bf16x8*)(MP + ni * 4096 + arow * 64 + acol); ra1[u] = *(const bf16x8*)(MP + ni * 4096 + arow * 64 + acol + 32);
                rgt[u] = *(const f32x4*)(GT + ni * 4096 + irow * 64 + jcol); rgm[u] = *(const f32x4*)(GAM + ni * 64 + jcol); }
            __syncthreads();
            const bf16x8 b0 = *(const LAS bf16x8*)(lds + buf * 4608 + (vl * 16 + (lane & 15)) * TS + (lane >> 4) * 16);
            const bf16x8 b1 = *(const LAS bf16x8*)(lds + buf * 4608 + (vl * 16 + (lane & 15)) * TS + (lane >> 4) * 16 + 64);
            acc = cgm * acc + cgt;
            acc = __builtin_amdgcn_mfma_f32_16x16x32_bf16(ca0, b0, acc, 0, 0, 0);
            acc = __builtin_amdgcn_mfma_f32_16x16x32_bf16(ca1, b1, acc, 0, 0, 0);
            buf ^= 1;
        }
    }
}

__device__ void phase_out(const Params& p) {
    const int tid = threadIdx.x, wid = tid >> 6, lane = tid & 63, sub = wid >> 2, mt = wid & 3;
    const bf16_t* Pm = (const bf16_t*)(p.ws + WS_P); const bf16_t* HST = (const bf16_t*)(p.ws + WS_HST); const float* Q = p.out;
    const bf16_t* GA = (const bf16_t*)(p.ws + WS_GATE); const bf16_t* BO = (const bf16_t*)(p.ws + WS_BONUS); bf16_t* mix = (bf16_t*)(p.ws + WS_MIX);
    for (int u = (int)blockIdx.x; u < 1024; u += (int)gridDim.x) {
        const size_t item = (size_t)u * 2 + sub; const int h = (int)(item & 7), c = (int)((item >> 3) & 127), b = (int)(item >> 10);
        const int tr = mt * 16 + (lane & 15);
        const bf16x8 a0 = *(const bf16x8*)(Pm + item * 4096 + tr * 64 + 8 * (lane >> 4)), a1 = *(const bf16x8*)(Pm + item * 4096 + tr * 64 + 8 * (lane >> 4) + 32);
        f32x4 y[4]; float s = 0.f;
#pragma unroll
        for (int n = 0; n < 4; ++n) {
            const bf16_t* hp = HST + item * 4096 + (n * 16 + (lane & 15)) * 64 + 8 * (lane >> 4);
            const bf16x8 b0 = *(const bf16x8*)hp, b1 = *(const bf16x8*)(hp + 32);
            f32x4 acc = *(const f32x4*)(Q + item * 4096 + tr * 64 + n * 16 + 4 * (lane >> 4));
            acc = __builtin_amdgcn_mfma_f32_16x16x32_bf16(b0, a0, acc, 0, 0, 0);
            acc = __builtin_amdgcn_mfma_f32_16x16x32_bf16(b1, a1, acc, 0, 0, 0);
            y[n] = acc; s += acc[0] + acc[1] + acc[2] + acc[3];
        }
        s += __shfl_xor(s, 16); s += __shfl_xor(s, 32);
        const float mu = s * (1.f / 64.f); float vs = 0.f;
#pragma unroll
        for (int n = 0; n < 4; ++n)
#pragma unroll
            for (int e = 0; e < 4; ++e) { const float d = y[n][e] - mu; vs += d * d; }
        vs += __shfl_xor(vs, 16); vs += __shfl_xor(vs, 32);
        const float rstd = rsqrtf(vs * (1.f / 64.f) + 64e-5f);
        const size_t orow = (size_t)(b * SEQ + c * 64 + tr) * DM + 512 + h * 64;
#pragma unroll
        for (int n = 0; n < 4; ++n) { const int i0 = n * 16 + 4 * (lane >> 4);
            const float4 lw = *(const float4*)(p.lnx_w + h * 64 + i0), lb = *(const float4*)(p.lnx_b + h * 64 + i0);
            const u32x2 gv = *(const u32x2*)(GA + item * 4096 + tr * 64 + i0), bv = *(const u32x2*)(BO + item * 4096 + tr * 64 + i0);
            const float g0 = bf2f(gv[0] & 0xffffu), g1 = __uint_as_float(gv[0] & 0xffff0000u), g2 = bf2f(gv[1] & 0xffffu), g3 = __uint_as_float(gv[1] & 0xffff0000u);
            const float o0 = bf2f(bv[0] & 0xffffu), o1 = __uint_as_float(bv[0] & 0xffff0000u), o2 = bf2f(bv[1] & 0xffffu), o3 = __uint_as_float(bv[1] & 0xffff0000u);
            const float r0 = ((y[n][0] - mu) * rstd * lw.x + lb.x + o0) * g0, r1 = ((y[n][1] - mu) * rstd * lw.y + lb.y + o1) * g1,
                        r2 = ((y[n][2] - mu) * rstd * lw.z + lb.z + o2) * g2, r3 = ((y[n][3] - mu) * rstd * lw.w + lb.w + o3) * g3;
            *(u32x2*)(mix + orow + i0) = (u32x2){cvt_pk_bf16(r0, r1), cvt_pk_bf16(r2, r3)}; }
    }
}


#ifndef DIAG
#define DIAG 0
#endif
__device__ void dump_bf16(const bf16_t* src, int ld, int coff, float* out) {
    for (size_t i = (size_t)blockIdx.x * 512 + threadIdx.x; i < (size_t)MTOK * DM; i += (size_t)gridDim.x * 512) {
        const size_t r = i >> 10, c = i & 1023; float v = bf2f(src[r * ld + coff + c]); if (!(v == v) || fabsf(v) > 1e30f) v = 7777.f; out[i] = v; }
}
__global__ void __launch_bounds__(512, 2) fwd_megakernel(Params p) {
    extern __shared__ __attribute__((aligned(16))) unsigned char shm[];
    LAS unsigned char* lds = (LAS unsigned char*)shm;
    cg::grid_group grid = cg::this_grid();
    if (p.ws == nullptr) grid.sync();
    if (threadIdx.x < 4) *(volatile LAS unsigned*)(lds + LDS_ST + threadIdx.x * 4) = 0u;
    __syncthreads();
    const XcdBarrier xbar = xcd_barrier_post((unsigned*)(p.ws + WS_BAR), (volatile LAS unsigned*)(lds + LDS_ST));
#define GSYNC() xcd_barrier(xbar)
    float* mod = (float*)(p.ws + WS_MOD);
    phase0(lds, p);
    GSYNC();
    phase_norm(p.x, p.norm1_g, mod, 0, 1024, (bf16_t*)(p.ws + WS_H));
    GSYNC();
    { EpiZ e; e.O = (bf16_t*)(p.ws + WS_Z); e.ldc = INC; run_gemm(lds, (const bf16_t*)(p.ws + WS_H), (const bf16_t*)(p.ws + WS_WIN), INC, 1024, e); }
    if (blockIdx.x >= 64) conv_run((LAS float*)lds, p, 624 + (int)blockIdx.x - 64, (int)gridDim.x - 64, 2992);
    GSYNC();
    if (DIAG == 2) { dump_bf16((const bf16_t*)(p.ws + WS_Z), INC, 0, p.out); return; }
    if (DIAG == 3) { dump_bf16((const bf16_t*)(p.ws + WS_Z), INC, 1024, p.out); return; }
    for (int it = (int)blockIdx.x; it < 2048; it += (int)gridDim.x) scan_pre_item(lds, p, it);
    GSYNC();
    if (blockIdx.x < 32) phase_state(lds, p);
    else for (int it = (int)blockIdx.x - 32; it < 1024; it += (int)gridDim.x - 32) pool_item(lds, p, it >> 2, it & 3);
    GSYNC();
    phase_out(p);
    GSYNC();
    if (DIAG == 5) { dump_bf16((const bf16_t*)(p.ws + WS_MIX), DM, 0, p.out); return; }
    { EpiRes e; e.xin = p.x; e.out = p.out; e.gate = mod + 2048; run_gemm(lds, (const bf16_t*)(p.ws + WS_MIX), (const bf16_t*)(p.ws + WS_WOUT), 1024, 1024, e); }
    GSYNC();
    phase_norm(p.out, p.norm2_g, mod, 3072, 4096, (bf16_t*)(p.ws + WS_H));
    GSYNC();
    { EpiAct e; e.O = (bf16_t*)(p.ws + WS_ACT); run_gemm(lds, (const bf16_t*)(p.ws + WS_H), (const bf16_t*)(p.ws + WS_WGU), 2 * DFF, 1024, e); }
    GSYNC();
    { EpiRes e; e.xin = p.out; e.out = p.out; e.gate = mod + 5120; run_gemm(lds, (const bf16_t*)(p.ws + WS_ACT), (const bf16_t*)(p.ws + WS_WDN), 1024, DFF, e); }
    GSYNC();
    phase_final(p.out, p.final_g);
}

extern "C" void kernel_launch(void* const* d_in, const int* in_sizes, int n_in, void* d_out, int out_size, void* d_ws, size_t ws_size, hipStream_t stream) {
    static int grid_blocks = 0;
    if (!grid_blocks) {
        int dev = 0, cus = 0, per_cu = 0;
        hipGetDevice(&dev);
        hipDeviceGetAttribute(&cus, hipDeviceAttributeMultiprocessorCount, dev);
        hipFuncSetAttribute((const void*)fwd_megakernel, hipFuncAttributeMaxDynamicSharedMemorySize, LDS_BYTES);
        hipOccupancyMaxActiveBlocksPerMultiprocessor(&per_cu, (const void*)fwd_megakernel, 512, LDS_BYTES);
        if (per_cu < 1) { fprintf(stderr, "occupancy query says %d blocks/CU\n", per_cu); per_cu = 1; }
        grid_blocks = cus * 1;
        (void)hipGetLastError();
    }
    Params p{};
    const float** f = (const float**)&p;
    for (int i = 0; i < 24; ++i) f[i] = (const float*)d_in[i];
    p.out = (float*)d_out; p.ws = (unsigned char*)d_ws;
    (void)hipMemsetAsync((unsigned char*)d_ws + WS_BAR, 0, XCD_BAR_WORDS * sizeof(unsigned), stream);
    (void)hipMemsetAsync((unsigned char*)d_ws + WS_MOD, 0, 2 * 6144 * sizeof(float), stream);
    void* args[] = {&p};
    hipError_t e = hipLaunchCooperativeKernel((const void*)fwd_megakernel, dim3(grid_blocks), dim3(512), args, LDS_BYTES, stream);
    if (e != hipSuccess) fprintf(stderr, "cooperative launch failed: %s (grid %d)\n", hipGetErrorString(e), grid_blocks);
}
```

```cpp
#include <hip/hip_runtime.h>
#include <hip/hip_cooperative_groups.h>
#include <cstdio>
namespace cg = cooperative_groups;
namespace pg8 {
#define PG8_LAS __attribute__((address_space(3)))
typedef unsigned short bf16_t;
typedef short bf16x8 __attribute__((ext_vector_type(8)));
typedef float f32x4 __attribute__((ext_vector_type(4)));
typedef unsigned u32x4 __attribute__((ext_vector_type(4)));
constexpr int BM = 256, BK = 64, HALF = 128, HTB = HALF * BK * 2  , STAGE_BYTES = 8 * HTB, NXCD = 8, WGM = 8;

__host__ __device__ __forceinline__ int lds_byte(int r, int c) { const int st = (r >> 4) * 2 + (c >> 5), rr = r & 15, cc = c & 31, ob = rr * 64 + cc * 2; return st * 1024 + (ob ^ (((ob >> 9) & 1) << 5)); }
__host__ __device__ __forceinline__ void stage_rc(int b, int& R, int& C) { const int st = b / 1024, sb = b % 1024, swz = sb ^ (((sb >> 9) & 1) << 5); R = (st >> 1) * 16 + swz / 64; C = (st & 1) * 32 + (swz % 64) / 2; }
__host__ __device__ __forceinline__ int perm32(int rho) { const int n = rho >> 4, i = rho & 15; return 8 * (i >> 2) + 4 * n + (i & 3); }

struct Unit { int pm, pn; };
struct Gemm { const bf16_t* A; const bf16_t* Bt; int M, N, K; };

struct StaticOrder {
    int nM, nN, nwg, G, c;
    __host__ __device__ void init(int M, int N, int G_, int c_) { nM = M / BM; nN = N / BM; nwg = nM * nN; G = G_; c = c_; }
    __host__ __device__ bool next(int i, Unit& u) const {
        const long L = (long)i * G + c; if (L >= nwg) return false;
        int wgid = (int)L; { const int q = nwg / NXCD, r = nwg % NXCD, xcd = wgid % NXCD, off = wgid / NXCD; wgid = (xcd < r ? xcd * (q + 1) : r * (q + 1) + (xcd - r) * q) + off; }
        const int nig = WGM * nN, gid = wgid / nig, fm = gid * WGM, gsz = (nM - fm) < WGM ? (nM - fm) : WGM;
        u.pm = fm + ((wgid % nig) % gsz); u.pn = (wgid % nig) / gsz; return true;
    }
    __device__ __forceinline__ void a_ready(const Unit&) const {}
    __device__ __forceinline__ void done(const Unit&) const {}
};
typedef float f32x2_t __attribute__((ext_vector_type(2)));
typedef __bf16 bf16x2_t __attribute__((ext_vector_type(2)));
__device__ __forceinline__ unsigned cvt_pk_bf16(float lo, float hi) { const f32x2_t v = {lo, hi}; const bf16x2_t r = __builtin_convertvector(v, bf16x2_t); return __builtin_bit_cast(unsigned, r); }

template <class Epi, class Sched, bool STAMP = false>
__device__ __forceinline__ void gemm_phase(PG8_LAS unsigned char* lds, const Gemm g, const Sched& S, const Epi& E, unsigned long long* stamps) {
    const int tid = threadIdx.x, wid = __builtin_amdgcn_readfirstlane(tid >> 6), lane = tid & 63, wr = wid >> 2, wc = wid & 3, fr = lane & 15, fq = lane >> 4;
    const int K = g.K, nt = K / BK;
    int ts_lo = 0, ts_hi = 0, nts = 0; const unsigned long long rt_entry = STAMP ? (unsigned long long)wall_clock64() : 0ull;
#define PG8_STAMP() do { if (STAMP && wid == 0 && nts < 64) { const unsigned long long _c = (unsigned long long)clock64(); \
        ts_lo = (lane == nts) ? (int)(unsigned)_c : ts_lo; ts_hi = (lane == nts) ? (int)(unsigned)(_c >> 32) : ts_hi; ++nts; } } while (0)
    PG8_STAMP();
    unsigned voffA[2], voffB[2];
#pragma unroll
    for (int i = 0; i < 2; ++i) { int R, C; stage_rc(tid * 16 + i * 8192, R, C); const int Rb = Epi::PERM ? ((R & ~31) + perm32(R & 31)) : R;
        voffA[i] = (unsigned)(R * K + C) * 2u; voffB[i] = (unsigned)(Rb * K + C) * 2u; }
    const size_t kstep = (size_t)(BK * 2);
    const size_t hstep = (size_t)HALF * K * 2;
    const size_t tstep = 2 * hstep;
    const unsigned ldsw = (unsigned)wid * 1024u;
    const int aoff = lds_byte(wr * 64 + fr, fq * 8), boff = lds_byte(wc * 32 + fr, fq * 8);
#define PG8_SA(b, h) (((b) * 2 + (h)) * HTB)
#define PG8_SB(b, h) ((4 + (b) * 2 + (h)) * HTB)
#define PG8_STAGE(bufoff, gbase, voff) do { _Pragma("unroll") for (int _i = 0; _i < 2; ++_i) \
        __builtin_amdgcn_global_load_lds((const unsigned*)((const char*)(gbase) + (voff)[_i]), (PG8_LAS unsigned*)(lds + (bufoff) + ldsw + _i * 8192), 16, 0, 0); } while (0)
#define PG8_LDA(dst, b, h) do { _Pragma("unroll") for (int m = 0; m < 4; ++m) _Pragma("unroll") for (int k = 0; k < 2; ++k) dst[m][k] = *(const PG8_LAS bf16x8*)(lds + PG8_SA(b, h) + aoff + m * 2048 + k * 1024); } while (0)
#define PG8_LDB(dst, b, h) do { _Pragma("unroll") for (int n = 0; n < 2; ++n) _Pragma("unroll") for (int k = 0; k < 2; ++k) dst[n][k] = *(const PG8_LAS bf16x8*)(lds + PG8_SB(b, h) + boff + n * 2048 + k * 1024); } while (0)
#define PG8_MMA(ai, bj, At, Bt) do { __builtin_amdgcn_s_setprio(1); _Pragma("unroll") for (int m = 0; m < 4; ++m) _Pragma("unroll") for (int n = 0; n < 2; ++n) _Pragma("unroll") for (int k = 0; k < 2; ++k) \
        acc[ai][bj][m][n] = __builtin_amdgcn_mfma_f32_16x16x32_bf16(Bt[n][k], At[m][k], acc[ai][bj][m][n], 0, 0, 0); __builtin_amdgcn_s_setprio(0); } while (0)
#define PG8_WAIT_V(n) asm volatile("s_waitcnt vmcnt(" #n ")" ::: "memory")
#define PG8_WAIT_L(n) asm volatile("s_waitcnt lgkmcnt(" #n ")" ::: "memory")
#define PG8_BAR __builtin_amdgcn_s_barrier()
#define PG8_SCHED __builtin_amdgcn_sched_barrier(0)
    Unit cur, nxt; int ui = 0;
    if (!S.next(0, cur)) return;
    f32x4 acc[2][2][4][2];
#pragma unroll
    for (int a = 0; a < 2; ++a)
#pragma unroll
        for (int b = 0; b < 2; ++b)
#pragma unroll
            for (int m = 0; m < 4; ++m)
#pragma unroll
                for (int n = 0; n < 2; ++n) acc[a][b][m][n] = (f32x4){0.f, 0.f, 0.f, 0.f};
    bf16x8 At[4][2], B0[2][2], B1[2][2];
    const char* cA = (const char*)g.A + (size_t)cur.pm * tstep; const char* cB = (const char*)g.Bt + (size_t)cur.pn * tstep;
    S.a_ready(cur);
    PG8_STAGE(PG8_SB(0, 0), cB, voffB); PG8_STAGE(PG8_SA(0, 0), cA, voffA); PG8_STAGE(PG8_SB(0, 1), cB + hstep, voffB); PG8_STAGE(PG8_SA(0, 1), cA + hstep, voffA);
    if (wr == 1) PG8_BAR;
    PG8_WAIT_V(4); PG8_BAR;
    PG8_STAGE(PG8_SB(1, 0), cB + kstep, voffB); PG8_STAGE(PG8_SA(1, 0), cA + kstep, voffA); PG8_STAGE(PG8_SB(1, 1), cB + hstep + kstep, voffB);
    PG8_WAIT_V(6); PG8_BAR;
    PG8_STAMP();
    for (;;) {
        const bool has_next = S.next(ui + 1, nxt);
        const char* nA = has_next ? (const char*)g.A + (size_t)nxt.pm * tstep : cA; const char* nB = has_next ? (const char*)g.Bt + (size_t)nxt.pn * tstep : cB;
        for (int t = 0; t < nt; t += 2) {
            const bool last = (t == nt - 2);
            const char* a1 = cA + (size_t)(t + 1) * kstep;
            const char* a2 = last ? nA : cA + (size_t)(t + 2) * kstep; const char* b2 = last ? nB : cB + (size_t)(t + 2) * kstep;
            const char* a3 = a2 + kstep; const char* b3 = b2 + kstep;
            if (last && has_next) S.a_ready(nxt);
            PG8_LDB(B0, 0, 0); PG8_SCHED; PG8_LDA(At, 0, 0); PG8_STAGE(PG8_SA(1, 1), a1 + hstep, voffA);
            PG8_WAIT_L(8); PG8_BAR; PG8_WAIT_L(0); PG8_MMA(0, 0, At, B0); PG8_BAR; PG8_SCHED;
            PG8_LDB(B1, 0, 1); PG8_STAGE(PG8_SB(0, 0), b2, voffB);
            PG8_BAR; PG8_WAIT_L(0); PG8_MMA(0, 1, At, B1); PG8_BAR;
            PG8_LDA(At, 0, 1); PG8_STAGE(PG8_SA(0, 0), a2, voffA);
            PG8_BAR; PG8_WAIT_L(0); PG8_MMA(1, 0, At, B0); PG8_BAR; PG8_SCHED;
            PG8_STAGE(PG8_SB(0, 1), b2 + hstep, voffB);
            PG8_WAIT_V(6); PG8_BAR; PG8_MMA(1, 1, At, B1); PG8_BAR;
            PG8_LDB(B0, 1, 0); PG8_SCHED; PG8_LDA(At, 1, 0); PG8_STAGE(PG8_SA(0, 1), a2 + hstep, voffA);
            PG8_WAIT_L(8); PG8_BAR; PG8_WAIT_L(0); PG8_MMA(0, 0, At, B0); PG8_BAR; PG8_SCHED;
            PG8_LDB(B1, 1, 1); PG8_STAGE(PG8_SB(1, 0), b3, voffB);
            PG8_BAR; PG8_WAIT_L(0); PG8_MMA(0, 1, At, B1); PG8_BAR;
            PG8_LDA(At, 1, 1); PG8_STAGE(PG8_SA(1, 0), a3, voffA);
            PG8_BAR; PG8_WAIT_L(0); PG8_MMA(1, 0, At, B0); PG8_BAR; PG8_SCHED;
            PG8_STAGE(PG8_SB(1, 1), b3 + hstep, voffB);
            PG8_WAIT_V(6); PG8_BAR; PG8_MMA(1, 1, At, B1); PG8_BAR;
        }
        PG8_STAMP();
        if constexpr (!Epi::AFTER_DRAIN) { E(acc, cur, wr, wc, fr, fq); S.done(cur); }
        PG8_STAMP();
        if (!has_next) break;
#pragma unroll
        for (int a = 0; a < 2; ++a)
#pragma unroll
            for (int b = 0; b < 2; ++b)
#pragma unroll
                for (int m = 0; m < 4; ++m)
#pragma unroll
                    for (int n = 0; n < 2; ++n) acc[a][b][m][n] = (f32x4){0.f, 0.f, 0.f, 0.f};
        cur = nxt; cA = nA; cB = nB; ++ui;
    }
    PG8_WAIT_V(0);
    if (wr == 0) PG8_BAR;
    PG8_BAR;
    if constexpr (Epi::AFTER_DRAIN) { E.fused(acc, cur, wr, wc, fr, fq, lds, wid, lane); S.done(cur); }
    PG8_STAMP();
    if (STAMP && wid == 0) { stamps[lane] = lane < nts ? (((unsigned long long)(unsigned)ts_hi << 32) | (unsigned)ts_lo) : 0ull;
        if (lane == 62) stamps[62] = rt_entry; if (lane == 63) stamps[63] = (unsigned long long)wall_clock64(); }
#undef PG8_STAMP
#undef PG8_SA
#undef PG8_SB
#undef PG8_STAGE
#undef PG8_LDA
#undef PG8_LDB
#undef PG8_MMA
#undef PG8_WAIT_V
#undef PG8_WAIT_L
#undef PG8_BAR
#undef PG8_SCHED
}
}

using pg8::bf16_t; using pg8::bf16x8; using pg8::f32x4; using pg8::u32x4; using pg8::cvt_pk_bf16;
#define LAS __attribute__((address_space(3)))
typedef unsigned u32x2 __attribute__((ext_vector_type(2)));

constexpr int MTOK = 16384, DM = 1024, INC = 2304, DFF = 2816, SEQ = 8192;
constexpr size_t MiB = 1ull << 20;
constexpr size_t WS_WIN = 0, WS_WOUT = 4718592, WS_WGU = 6815744, WS_WDN = 18350080, WS_WPOOL = 24117248, WS_WDEC = 24248320,
                 WS_WICLR = 24313856, WS_WGATE = 24379392, WS_MOD = 24510464, WS_GAM = 24559616,
                 WS_H = 24 * MiB, WS_MP = 24 * MiB, WS_P = 40 * MiB, WS_Z = 56 * MiB, WS_ACT = 56 * MiB, WS_GATE = 128 * MiB,
                 WS_BONUS = 144 * MiB, WS_HST = 160 * MiB, WS_MIX = 176 * MiB;
constexpr int LDS_ST = 143360;
constexpr int LDS_BYTES = 143376;
constexpr size_t WS_BAR = 208 * MiB;
constexpr int TS = 144;
constexpr int R_AT = 0, R_BT = 9216, R_KT = 18432, R_RT = 27648, R_VT = 36864, R_BH = 46080, R_KH = 55296, R_AAK = 64512, R_ARB = 73728, R_ARK = 82944,
              R_AAB = 92160, R_RHS = 108544;
constexpr int R_TX = R_AT, R_XA = R_BT, R_SG = R_KT  , R_WT = R_AT, R_UT = R_BT;
constexpr int R_DL = R_AAK  , R_SEG = R_ARK, R_AL = R_RHS, R_GG = R_RHS + 17408;
constexpr int FS = 272;
constexpr int RS = 544;

struct Params {
    const float *x, *c, *ada_w, *ada_b, *norm1_g, *w_in, *mu_shift, *pool_w, *pool_scale, *w0, *w_decay_up, *a0, *w_iclr_up, *w_gate_up,
                *k_k, *k_a, *r_k, *lnx_w, *lnx_b, *w_out, *norm2_g, *w_ffn_gu, *w_ffn_down, *final_g;
    float* out; unsigned char* ws;
};

__device__ __forceinline__ float bf2f(unsigned v) { return __uint_as_float(v << 16); }
__device__ __forceinline__ float wave_sum(float v) {
#pragma unroll
    for (int o = 32; o > 0; o >>= 1) v += __shfl_xor(v, o);
    return v;
}
__device__ __forceinline__ float quad_sum(float v) {
    int t = __builtin_amdgcn_update_dpp(0, __float_as_int(v), 0xB1, 0xF, 0xF, true); v += __int_as_float(t);
    t = __builtin_amdgcn_update_dpp(0, __float_as_int(v), 0x4E, 0xF, 0xF, true); v += __int_as_float(t);
    return v;
}
__device__ __forceinline__ void unpack8(u32x4 v, float (&f)[8]) {
#pragma unroll
    for (int i = 0; i < 4; ++i) { f[2 * i] = __uint_as_float(v[i] << 16); f[2 * i + 1] = __uint_as_float(v[i] & 0xffff0000u); }
}
__device__ __forceinline__ u32x4 pack8(const float (&f)[8]) { return (u32x4){cvt_pk_bf16(f[0], f[1]), cvt_pk_bf16(f[2], f[3]), cvt_pk_bf16(f[4], f[5]), cvt_pk_bf16(f[6], f[7])}; }
__device__ __forceinline__ unsigned short f2bf(float f) { return (unsigned short)(cvt_pk_bf16(f, 0.f) & 0xffffu); }

__device__ __forceinline__ f32x4 mm_lds(const LAS unsigned char* A, int sa, int m0, const LAS unsigned char* Bt, int sb, int n0, int K, int lane, f32x4 acc) {
    const LAS unsigned char* ap = A + (m0 + (lane & 15)) * sa + (lane >> 4) * 16;
    const LAS unsigned char* bp = Bt + (n0 + (lane & 15)) * sb + (lane >> 4) * 16;
#pragma unroll
    for (int k0 = 0; k0 < K; k0 += 32) {
        const bf16x8 a = *(const LAS bf16x8*)(ap + k0 * 2), b = *(const LAS bf16x8*)(bp + k0 * 2);
        acc = __builtin_amdgcn_mfma_f32_16x16x32_bf16(b, a, acc, 0, 0, 0);
    }
    return acc;
}
__device__ __forceinline__ f32x4 mm_lds_g(const LAS unsigned char* A, int sa, int m0, const unsigned char* Bt, int sb, int n0, int K, int lane, f32x4 acc) {
    const LAS unsigned char* ap = A + (m0 + (lane & 15)) * sa + (lane >> 4) * 16;
    const unsigned char* bp = Bt + (size_t)(n0 + (lane & 15)) * sb + (lane >> 4) * 16;
#pragma unroll
    for (int k0 = 0; k0 < K; k0 += 32) {
        const bf16x8 a = *(const LAS bf16x8*)(ap + k0 * 2), b = *(const bf16x8*)(bp + k0 * 2);
        acc = __builtin_amdgcn_mfma_f32_16x16x32_bf16(b, a, acc, 0, 0, 0);
    }
    return acc;
}

#define XB_TMO      128
#define XB_XCNT(j)  (256  + 64 * (j))
#define XB_XSUB(j)  (1280 + 64 * (j))
#define XB_XGEN(j)  (2304 + 64 * (j))
#define XB_TOP      3328
#define XB_TOPGEN   3392
#define XCD_BAR_WORDS 3456
#define XB_SPIN_CAP (1u << 18)

__device__ __forceinline__ unsigned xb_ld(unsigned* p)              { return __hip_atomic_load(p, __ATOMIC_RELAXED, __HIP_MEMORY_SCOPE_AGENT); }
__device__ __forceinline__ unsigned xb_add(unsigned* p, unsigned v) { return __hip_atomic_fetch_add(p, v, __ATOMIC_RELAXED, __HIP_MEMORY_SCOPE_AGENT); }
__device__ __forceinline__ unsigned xb_xcc_id() { return (unsigned)__builtin_amdgcn_s_getreg((3 << 11) | 20) & 0xFu; }
#define XB_SPIN(cond, bar) do { unsigned _sp = 0; while (cond) { __builtin_amdgcn_s_sleep(1); \
    if ((++_sp & 255u) == 0u) { if (xb_ld(&(bar)[XB_TMO])) break; if (_sp > XB_SPIN_CAP) { atomicAdd(&(bar)[XB_TMO], 1u); break; } } } } while (0)

struct XcdBarrier {
    unsigned* bar; unsigned x;
    volatile LAS unsigned* st;
};

__device__ __forceinline__ XcdBarrier xcd_barrier_post(unsigned* bar, volatile LAS unsigned* st) {
    XcdBarrier b; b.bar = bar; b.x = xb_xcc_id(); b.st = st;
    if (threadIdx.x == 0) (void)xb_add(&bar[XB_XCNT(b.x)], 1u);
    return b;
}
__device__ __forceinline__ void xcd_barrier_complete(unsigned* bar, unsigned x, unsigned& nloc, unsigned& nx) {
    const unsigned G = gridDim.x * gridDim.y * gridDim.z;
    unsigned sum, cnt, mine, sp = 0u;
    for (;;) {
        sum = 0u; cnt = 0u; mine = 0u;
#pragma unroll
        for (unsigned j = 0; j < 16; ++j) { const unsigned c = xb_ld(&bar[XB_XCNT(j)]); sum += c; cnt += (c > 0u) ? 1u : 0u; mine = (j == x) ? c : mine; }
        if (sum == G) break;
        __builtin_amdgcn_s_sleep(1);
        if ((++sp & 255u) == 0u) { if (xb_ld(&bar[XB_TMO])) break; if (sp > XB_SPIN_CAP) { atomicAdd(&bar[XB_TMO], 1u); break; } }
    }
    nloc = mine > 0u ? mine : 1u; nx = cnt > 0u ? cnt : 1u;
}

__device__ __forceinline__ void xcd_barrier(const XcdBarrier& b) {
    asm volatile("s_waitcnt vmcnt(0)" ::: "memory");
    __syncthreads();
    if (threadIdx.x == 0) {
        unsigned* bar = b.bar;
        __builtin_amdgcn_s_waitcnt(0);
        unsigned nloc = b.st[0], nx = b.st[1];
        if (nloc == 0u) { xcd_barrier_complete(bar, b.x, nloc, nx); b.st[0] = nloc; b.st[1] = nx; }
        const unsigned old = xb_add(&bar[XB_XSUB(b.x)], 1u);
        const unsigned gen = old / nloc;
        if (old + 1u == (gen + 1u) * nloc) {
            __builtin_amdgcn_fence(__ATOMIC_RELEASE, "agent");
            asm volatile("s_waitcnt vmcnt(0)" ::: "memory");
            const unsigned og = xb_add(&bar[XB_TOP], 1u);
            const unsigned tg = og / nx;
            if (og + 1u == (tg + 1u) * nx) xb_add(&bar[XB_TOPGEN], 1u);
            else XB_SPIN(xb_ld(&bar[XB_TOPGEN]) == tg, bar);
            __builtin_amdgcn_fence(__ATOMIC_ACQUIRE, "agent");
            xb_add(&bar[XB_XGEN(b.x)], 1u);
            asm volatile("s_waitcnt vmcnt(0)" ::: "memory");
        } else {
            XB_SPIN(xb_ld(&bar[XB_XGEN(b.x)]) == gen, bar);
            __builtin_amdgcn_fence(__ATOMIC_ACQUIRE, "agent");
            asm volatile("s_waitcnt vmcnt(0)" ::: "memory");
        }
    }
    __syncthreads();
}

struct ConvJob { const float* src; bf16_t* dst; int K, N, mode, kt, nt; };
__device__ __forceinline__ ConvJob conv_job(const Params& p, int t) {
    ConvJob j; j.mode = 0; int loc;
    if (t < 576) { loc = t; j.src = p.w_in; j.dst = (bf16_t*)(p.ws + WS_WIN); j.K = 1024; j.N = INC; }
    else if (t < 592) { const int g = (t - 576) >> 2; loc = (t - 576) & 3; j.src = p.pool_w + g * 16384; j.dst = (bf16_t*)(p.ws + WS_WPOOL) + g * 16384; j.K = 128; j.N = 128; }
    else if (t < 600) { loc = t - 592; j.src = p.w_decay_up; j.dst = (bf16_t*)(p.ws + WS_WDEC); j.K = 64; j.N = 512; }
    else if (t < 608) { loc = t - 600; j.src = p.w_iclr_up; j.dst = (bf16_t*)(p.ws + WS_WICLR); j.K = 64; j.N = 512; }
    else if (t < 624) { loc = t - 608; j.src = p.w_gate_up; j.dst = (bf16_t*)(p.ws + WS_WGATE); j.K = 128; j.N = 512; }
    else if (t < 880) { loc = t - 624; j.src = p.w_out; j.dst = (bf16_t*)(p.ws + WS_WOUT); j.K = 1024; j.N = 1024; }
    else if (t < 2288) { loc = t - 880; j.src = p.w_ffn_gu; j.dst = (bf16_t*)(p.ws + WS_WGU); j.K = 1024; j.N = 2 * DFF; j.mode = 1; }
    else { loc = t - 2288; j.src = p.w_ffn_down; j.dst = (bf16_t*)(p.ws + WS_WDN); j.K = DFF; j.N = 1024; }
    const int ntn = j.N / 64; j.kt = loc / ntn; j.nt = loc % ntn; return j;
}
__device__ void conv_run(LAS float* tile, const Params& p, int first, int stride, int hi) {
    const int tid = threadIdx.x, r = tid >> 4, c4 = (tid & 15) * 4, n = tid >> 3, k8 = (tid & 7) * 8;
    if (first >= hi) return;
    ConvJob j = conv_job(p, first);
    float4 v0 = *(const float4*)(j.src + (size_t)(j.kt * 64 + r) * j.N + j.nt * 64 + c4), v1 = *(const float4*)(j.src + (size_t)(j.kt * 64 + r + 32) * j.N + j.nt * 64 + c4);
    for (int t = first; t < hi; t += stride) {
        tile[r * 65 + c4 + 0] = v0.x; tile[r * 65 + c4 + 1] = v0.y; tile[r * 65 + c4 + 2] = v0.z; tile[r * 65 + c4 + 3] = v0.w;
        tile[(r + 32) * 65 + c4 + 0] = v1.x; tile[(r + 32) * 65 + c4 + 1] = v1.y; tile[(r + 32) * 65 + c4 + 2] = v1.z; tile[(r + 32) * 65 + c4 + 3] = v1.w;
        __syncthreads();
        const ConvJob cj = j;
        if (t + stride < hi) { j = conv_job(p, t + stride);
            v0 = *(const float4*)(j.src + (size_t)(j.kt * 64 + r) * j.N + j.nt * 64 + c4); v1 = *(const float4*)(j.src + (size_t)(j.kt * 64 + r + 32) * j.N + j.nt * 64 + c4); }
        float f[8];
#pragma unroll
        for (int e = 0; e < 8; ++e) f[e] = tile[(k8 + e) * 65 + n];
        const int col = cj.nt * 64 + n; int drow = col;
        if (cj.mode == 1) drow = col < DFF ? (col / 128) * 256 + (col % 128) : ((col - DFF) / 128) * 256 + 128 + ((col - DFF) % 128);
        *(u32x4*)(cj.dst + (size_t)drow * cj.K + cj.kt * 64 + k8) = pack8(f);
        __syncthreads();
    }
}
__device__ __forceinline__ void mod_unit(LAS float* red, const Params& p, int u) {
    const int tid = threadIdx.x, w = tid >> 6, lane = tid & 63, cu = u >> 1, kh = u & 1, n = cu * 64 + lane;
    float a0 = 0.f, a1 = 0.f;
    const int kb = kh * 512 + w * 64;
#pragma unroll 16
    for (int k = kb; k < kb + 64; ++k) {
        const float wv = p.ada_w[(size_t)k * 6144 + n]; const float c0 = p.c[k], c1 = p.c[1024 + k];
        a0 += (c0 / (1.f + __expf(-c0))) * wv; a1 += (c1 / (1.f + __expf(-c1))) * wv;
    }
    red[(w * 2 + 0) * 64 + lane] = a0; red[(w * 2 + 1) * 64 + lane] = a1;
    __syncthreads();
    if (tid < 128) { const int b = tid >> 6; float s = 0.f;
#pragma unroll
        for (int w2 = 0; w2 < 8; ++w2) s += red[(w2 * 2 + b) * 64 + lane];
        if (kh == 0) s += p.ada_b[n];
        atomicAdd((float*)(p.ws + WS_MOD) + b * 6144 + n, s); }
    __syncthreads();
}
__device__ void phase0(LAS unsigned char* lds, const Params& p) {
    if (blockIdx.x < 192) mod_unit((LAS float*)lds, p, blockIdx.x);
    conv_run((LAS float*)lds, p, (int)blockIdx.x, (int)gridDim.x, 624);
}

__device__ void phase_norm(const float* X, const float* g, const float* mod, int sh_off, int sc_off, bf16_t* H) {
    const int wid = threadIdx.x >> 6, lane = threadIdx.x & 63;
    const int nw = (int)gridDim.x * 8, gw = (int)blockIdx.x * 8 + wid;
#pragma unroll 1
    for (int b = 0; b < 2; ++b) {
        const float* mb = mod + b * 6144;
        float4 ga[4], sa[4];
#pragma unroll
        for (int j = 0; j < 4; ++j) { const int col = (j * 64 + lane) * 4;
            const float4 gg = *(const float4*)(g + col), sc = *(const float4*)(mb + sc_off + col); sa[j] = *(const float4*)(mb + sh_off + col);
            ga[j] = make_float4(gg.x * (1.f + sc.x), gg.y * (1.f + sc.y), gg.z * (1.f + sc.z), gg.w * (1.f + sc.w)); }
        int row = b * SEQ + gw;
        float4 v[4];
        if (row < (b + 1) * SEQ) {
#pragma unroll
            for (int j = 0; j < 4; ++j) v[j] = *(const float4*)(X + (size_t)row * DM + (j * 64 + lane) * 4); }
        for (; row < (b + 1) * SEQ; row += nw) {
            float4 c[4];
#pragma unroll
            for (int j = 0; j < 4; ++j) c[j] = v[j];
            if (row + nw < (b + 1) * SEQ) {
#pragma unroll
                for (int j = 0; j < 4; ++j) v[j] = *(const float4*)(X + (size_t)(row + nw) * DM + (j * 64 + lane) * 4); }
            float ss = 0.f;
#pragma unroll
            for (int j = 0; j < 4; ++j) ss += c[j].x * c[j].x + c[j].y * c[j].y + c[j].z * c[j].z + c[j].w * c[j].w;
            ss = wave_sum(ss); const float rstd = rsqrtf(ss * (1.f / 1024.f) + 1e-6f);
#pragma unroll
            for (int j = 0; j < 4; ++j) { const int col = (j * 64 + lane) * 4;
                const float h0 = (c[j].x * rstd) * ga[j].x + sa[j].x, h1 = (c[j].y * rstd) * ga[j].y + sa[j].y, h2 = (c[j].z * rstd) * ga[j].z + sa[j].z, h3 = (c[j].w * rstd) * ga[j].w + sa[j].w;
                *(u32x2*)(H + (size_t)row * DM + col) = (u32x2){cvt_pk_bf16(h0, h1), cvt_pk_bf16(h2, h3)}; }
        }
    }
}
__device__ void phase_final(float* X, const float* g) {
    const int wid = threadIdx.x >> 6, lane = threadIdx.x & 63;
    const int nw = (int)gridDim.x * 8, gw = (int)blockIdx.x * 8 + wid;
    float4 ga[4];
#pragma unroll
    for (int j = 0; j < 4; ++j) ga[j] = *(const float4*)(g + (j * 64 + lane) * 4);
    int row = gw;
    float4 v[4];
    if (row < MTOK) {
#pragma unroll
        for (int j = 0; j < 4; ++j) v[j] = *(const float4*)(X + (size_t)row * DM + (j * 64 + lane) * 4); }
    for (; row < MTOK; row += nw) {
        float4 c[4];
#pragma unroll
        for (int j = 0; j < 4; ++j) c[j] = v[j];
        if (row + nw < MTOK) {
#pragma unroll
            for (int j = 0; j < 4; ++j) v[j] = *(const float4*)(X + (size_t)(row + nw) * DM + (j * 64 + lane) * 4); }
        float ss = 0.f;
#pragma unroll
        for (int j = 0; j < 4; ++j) ss += c[j].x * c[j].x + c[j].y * c[j].y + c[j].z * c[j].z + c[j].w * c[j].w;
        ss = wave_sum(ss); const float rstd = rsqrtf(ss * (1.f / 1024.f) + 1e-6f);
#pragma unroll
        for (int j = 0; j < 4; ++j) { const int col = (j * 64 + lane) * 4;
            *(float4*)(X + (size_t)row * DM + col) = make_float4(c[j].x * rstd * ga[j].x, c[j].y * rstd * ga[j].y, c[j].z * rstd * ga[j].z, c[j].w * rstd * ga[j].w); }
    }
}

struct EpiZ {
    static constexpr bool PERM = true, AFTER_DRAIN = false;
    bf16_t* O; int ldc;
    __device__ __forceinline__ void operator()(const f32x4 (&acc)[2][2][4][2], const pg8::Unit& u, int wr, int wc, int fr, int fq) const {
        const int row0 = u.pm * 256 + wr * 64 + fr, col0 = u.pn * 256 + wc * 32 + 8 * fq;
#pragma unroll
        for (int ai = 0; ai < 2; ++ai)
#pragma unroll
            for (int m = 0; m < 4; ++m) { bf16_t* rowp = O + (size_t)(row0 + ai * 128 + m * 16) * ldc + col0;
#pragma unroll
                for (int bj = 0; bj < 2; ++bj) { const f32x4 v0 = acc[ai][bj][m][0], v1 = acc[ai][bj][m][1];
                    *(u32x4*)(rowp + bj * 128) = (u32x4){cvt_pk_bf16(v0[0], v0[1]), cvt_pk_bf16(v0[2], v0[3]), cvt_pk_bf16(v1[0], v1[1]), cvt_pk_bf16(v1[2], v1[3])}; } }
    }
};
struct EpiRes {
    static constexpr bool PERM = false, AFTER_DRAIN = false;
    const float* xin; float* out; const float* gate;
    __device__ __forceinline__ void operator()(const f32x4 (&acc)[2][2][4][2], const pg8::Unit& u, int wr, int wc, int fr, int fq) const {
        const int row0 = u.pm * 256 + wr * 64 + fr, col0 = u.pn * 256 + wc * 32 + 4 * fq;
        const float* gb = gate + (u.pm >> 5) * 6144;
        f32x4 gv[2][2];
#pragma unroll
        for (int bj = 0; bj < 2; ++bj)
#pragma unroll
            for (int n = 0; n < 2; ++n) gv[bj][n] = *(const f32x4*)(gb + col0 + bj * 128 + n * 16);
#pragma unroll
        for (int ai = 0; ai < 2; ++ai)
#pragma unroll
            for (int mp = 0; mp < 2; ++mp) {
                f32x4 xv[2][2][2];
#pragma unroll
                for (int mm = 0; mm < 2; ++mm) { const size_t ro = (size_t)(row0 + ai * 128 + (mp * 2 + mm) * 16) * DM + col0;
#pragma unroll
                    for (int bj = 0; bj < 2; ++bj)
#pragma unroll
                        for (int n = 0; n < 2; ++n) xv[mm][bj][n] = *(const f32x4*)(xin + ro + bj * 128 + n * 16); }
                asm volatile("" ::: "memory");
#pragma unroll
                for (int mm = 0; mm < 2; ++mm) { const size_t ro = (size_t)(row0 + ai * 128 + (mp * 2 + mm) * 16) * DM + col0;
#pragma unroll
                    for (int bj = 0; bj < 2; ++bj)
#pragma unroll
                        for (int n = 0; n < 2; ++n) *(f32x4*)(out + ro + bj * 128 + n * 16) = xv[mm][bj][n] + gv[bj][n] * acc[ai][bj][mp * 2 + mm][n]; }
                asm volatile("" ::: "memory");
            }
    }
};
struct EpiAct {
    static constexpr bool PERM = true, AFTER_DRAIN = false;
    bf16_t* O;
    __device__ __forceinline__ void operator()(const f32x4 (&acc)[2][2][4][2], const pg8::Unit& u, int wr, int wc, int fr, int fq) const {
        const int row0 = u.pm * 256 + wr * 64 + fr, col0 = u.pn * 128 + wc * 32 + 8 * fq;
#pragma unroll
        for (int ai = 0; ai < 2; ++ai)
#pragma unroll
            for (int m = 0; m < 4; ++m) { float r[8];
#pragma unroll
                for (int n = 0; n < 2; ++n)
#pragma unroll
                    for (int e = 0; e < 4; ++e) { const float gt = acc[ai][0][m][n][e], up = acc[ai][1][m][n][e]; r[n * 4 + e] = gt * __builtin_amdgcn_rcpf(1.f + __expf(-gt)) * up; }
                *(u32x4*)(O + (size_t)(row0 + ai * 128 + m * 16) * DFF + col0) = pack8(r); }
    }
};
template <class Epi> __device__ __forceinline__ void run_gemm(LAS unsigned char* lds, const bf16_t* A, const bf16_t* Bt, int N, int K, const Epi& E) {
    pg8::Gemm g; g.A = A; g.Bt = Bt; g.M = MTOK; g.N = N; g.K = K;
    pg8::StaticOrder S; S.init(MTOK, N, (int)gridDim.x, (int)blockIdx.x);
    pg8::gemm_phase<Epi, pg8::StaticOrder, false>(lds, g, S, E, nullptr);
}

__device__ void pool_item(LAS unsigned char* lds, const Params& p, int tt, int g) {
    const int tid = threadIdx.x, t = tid >> 3, cgp = tid & 7, wid = tid >> 6, lane = tid & 63;
    const bf16_t* Z = (const bf16_t*)(p.ws + WS_Z);
    const int row0 = tt * 64, tl0 = row0 & (SEQ - 1), w = 2 << g;
    constexpr int UOFF = 0, DOFF = 24576;
#pragma unroll
    for (int i = 0; i < 3; ++i) { const int pc = tid + i * 512;
        if (pc < 79 * 16) { const int r = pc >> 4, c16 = pc & 15; const int tl = tl0 - 15 + r;
            u32x4 v = {0u, 0u, 0u, 0u};
            if (tl >= 0) v = *(const u32x4*)(Z + (size_t)(row0 - 15 + r) * INC + g * 128 + c16 * 8);
            *(LAS u32x4*)(lds + UOFF + r * 272 + c16 * 16) = v; } }
    __syncthreads();
    { const int tl = tl0 + t, cnt = (tl + 1) < w ? (tl + 1) : w; const float inv = 1.f / (float)cnt;
      float s0[8], s1[8], u0[8], u1[8];
      const LAS unsigned char* up = lds + UOFF + (t + 15) * 272 + cgp * 32;
      unpack8(*(const LAS u32x4*)up, u0); unpack8(*(const LAS u32x4*)(up + 16), u1);
#pragma unroll
      for (int e = 0; e < 8; ++e) { s0[e] = u0[e]; s1[e] = u1[e]; }
      for (int q = 1; q < w; ++q) { float a[8], b[8]; unpack8(*(const LAS u32x4*)(up - q * 272), a); unpack8(*(const LAS u32x4*)(up - q * 272 + 16), b);
#pragma unroll
          for (int e = 0; e < 8; ++e) { s0[e] += a[e]; s1[e] += b[e]; } }
#pragma unroll
      for (int e = 0; e < 8; ++e) { s0[e] = s0[e] * inv - u0[e]; s1[e] = s1[e] * inv - u1[e]; }
      *(LAS u32x4*)(lds + DOFF + t * 272 + cgp * 32) = pack8(s0); *(LAS u32x4*)(lds + DOFF + t * 272 + cgp * 32 + 16) = pack8(s1); }
    __syncthreads();
    const unsigned char* Bt = p.ws + WS_WPOOL + (size_t)g * 32768;
    const float4 ps = *(const float4*)(p.pool_scale + g * 128 + wid * 16 + 4 * (lane >> 4));
    bf16_t* mix = (bf16_t*)(p.ws + WS_MIX);
#pragma unroll
    for (int m = 0; m < 4; ++m) {
        f32x4 acc = {0.f, 0.f, 0.f, 0.f};
        acc = mm_lds_g(lds + DOFF, 272, m * 16, Bt, 256, wid * 16, 128, lane, acc);
        const int orow = tt * 64 + m * 16 + (lane & 15), ocol = g * 128 + wid * 16 + 4 * (lane >> 4);
        *(u32x2*)(mix + (size_t)orow * DM + ocol) = (u32x2){cvt_pk_bf16(acc[0] * ps.x, acc[1] * ps.y), cvt_pk_bf16(acc[2] * ps.z, acc[3] * ps.w)};
    }
    __syncthreads();
}

__device__ __forceinline__ void shifted8(const bf16_t* Z, int row, bool has_prev, int col, const float* mu_shift, float (&o)[8]) {
    float cur[8], prv[8];
    unpack8(*(const u32x4*)(Z + (size_t)row * INC + col), cur);
    if (has_prev) unpack8(*(const u32x4*)(Z + (size_t)(row - 1) * INC + col), prv);
    else {
#pragma unroll
        for (int e = 0; e < 8; ++e) prv[e] = 0.f; }
    const float4 m0 = *(const float4*)(mu_shift + col - 512), m1 = *(const float4*)(mu_shift + col - 512 + 4);
    const float mu[8] = {m0.x, m0.y, m0.z, m0.w, m1.x, m1.y, m1.z, m1.w};
#pragma unroll
    for (int e = 0; e < 8; ++e) o[e] = cur[e] + (prv[e] - cur[e]) * mu[e];
}
__device__ void scan_pre_item(LAS unsigned char* lds, const Params& p, int item) {
    const int tid = threadIdx.x, t = tid >> 3, jg = tid & 7, wid = __builtin_amdgcn_readfirstlane(tid >> 6), lane = tid & 63;
    const int h = item & 7, c = (item >> 3) & 127, b = item >> 10;
    const bf16_t* Z = (const bf16_t*)(p.ws + WS_Z);
    const int row = b * SEQ + c * 64 + t; const bool has_prev = (c * 64 + t) > 0;
    const int hc = h * 64 + jg * 8;
    float r8[8], k8[8], v8[8];
    shifted8(Z, row, has_prev, 512 + hc, p.mu_shift, r8);
    shifted8(Z, row, has_prev, 1024 + hc, p.mu_shift, k8);
    shifted8(Z, row, has_prev, 1536 + hc, p.mu_shift, v8);
    { float f[8];
      shifted8(Z, row, has_prev, 2048 + jg * 8, p.mu_shift, f);
#pragma unroll
      for (int e = 0; e < 8; ++e) f[e] = 1.f - 2.f * __builtin_amdgcn_rcpf(__expf(2.f * f[e]) + 1.f);
      *(LAS u32x4*)(lds + R_TX + t * TS + jg * 16) = pack8(f);
      shifted8(Z, row, has_prev, 2112 + jg * 8, p.mu_shift, f);
      *(LAS u32x4*)(lds + R_XA + t * TS + jg * 16) = pack8(f);
#pragma unroll
      for (int hh = 0; hh < 2; ++hh) { shifted8(Z, row, has_prev, 2176 + jg * 16 + hh * 8, p.mu_shift, f);
#pragma unroll
          for (int e = 0; e < 8; ++e) f[e] = __builtin_amdgcn_rcpf(1.f + __expf(-f[e]));
          *(LAS u32x4*)(lds + R_SG + t * 272 + jg * 32 + hh * 16) = pack8(f); } }
    __syncthreads();
    { const int m = wid >> 1;
#pragma unroll
      for (int nn = 0; nn < 2; ++nn) { const int n = (wid & 1) * 2 + nn;
          f32x4 a0 = {0.f, 0.f, 0.f, 0.f}, a1 = a0, a2 = a0;
          a0 = mm_lds_g(lds + R_TX, TS, m * 16, p.ws + WS_WDEC + (size_t)h * 64 * 128, 128, n * 16, 64, lane, a0);
          a1 = mm_lds_g(lds + R_XA, TS, m * 16, p.ws + WS_WICLR + (size_t)h * 64 * 128, 128, n * 16, 64, lane, a1);
          a2 = mm_lds_g(lds + R_SG, 272, m * 16, p.ws + WS_WGATE + (size_t)h * 64 * 256, 256, n * 16, 128, lane, a2);
          const int off = (m * 16 + (lane & 15)) * FS + (n * 16 + 4 * (lane >> 4)) * 4;
          *(LAS f32x4*)(lds + R_DL + off) = a0; *(LAS f32x4*)(lds + R_AL + off) = a1; *(LAS f32x4*)(lds + R_GG + off) = a2; } }
    __syncthreads();
    float av8[8], bv8[8];
    { float dl[8], al[8], gg[8];
      { const f32x4 x0 = *(const LAS f32x4*)(lds + R_DL + t * FS + jg * 32), x1 = *(const LAS f32x4*)(lds + R_DL + t * FS + jg * 32 + 16);
        const f32x4 y0 = *(const LAS f32x4*)(lds + R_AL + t * FS + jg * 32), y1 = *(const LAS f32x4*)(lds + R_AL + t * FS + jg * 32 + 16);
        const f32x4 z0 = *(const LAS f32x4*)(lds + R_GG + t * FS + jg * 32), z1 = *(const LAS f32x4*)(lds + R_GG + t * FS + jg * 32 + 16);
#pragma unroll
        for (int e = 0; e < 4; ++e) { dl[e] = x0[e]; dl[4 + e] = x1[e]; al[e] = y0[e]; al[4 + e] = y1[e]; gg[e] = z0[e]; gg[4 + e] = z1[e]; } }
      float w0v[8], a0v[8], kkv[8], kav[8], rkv[8];
      { const float4 q0 = *(const float4*)(p.w0 + hc), q1 = *(const float4*)(p.w0 + hc + 4); w0v[0] = q0.x; w0v[1] = q0.y; w0v[2] = q0.z; w0v[3] = q0.w; w0v[4] = q1.x; w0v[5] = q1.y; w0v[6] = q1.z; w0v[7] = q1.w; }
      { const float4 q0 = *(const float4*)(p.a0 + hc), q1 = *(const float4*)(p.a0 + hc + 4); a0v[0] = q0.x; a0v[1] = q0.y; a0v[2] = q0.z; a0v[3] = q0.w; a0v[4] = q1.x; a0v[5] = q1.y; a0v[6] = q1.z; a0v[7] = q1.w; }
      { const float4 q0 = *(const float4*)(p.k_k + hc), q1 = *(const float4*)(p.k_k + hc + 4); kkv[0] = q0.x; kkv[1] = q0.y; kkv[2] = q0.z; kkv[3] = q0.w; kkv[4] = q1.x; kkv[5] = q1.y; kkv[6] = q1.z; kkv[7] = q1.w; }
      { const float4 q0 = *(const float4*)(p.k_a + hc), q1 = *(const float4*)(p.k_a + hc + 4); kav[0] = q0.x; kav[1] = q0.y; kav[2] = q0.z; kav[3] = q0.w; kav[4] = q1.x; kav[5] = q1.y; kav[6] = q1.z; kav[7] = q1.w; }
      { const float4 q0 = *(const float4*)(p.r_k + hc), q1 = *(const float4*)(p.r_k + hc + 4); rkv[0] = q0.x; rkv[1] = q0.y; rkv[2] = q0.z; rkv[3] = q0.w; rkv[4] = q1.x; rkv[5] = q1.y; rkv[6] = q1.z; rkv[7] = q1.w; }
      float ld[8], aa[8], kk[8]; float ssq = 0.f;
#pragma unroll
      for (int e = 0; e < 8; ++e) {
          const float xx = w0v[e] + dl[e];
          const float sp = fmaxf(-xx, 0.f) + __logf(1.f + __expf(-fabsf(xx)));
          ld[e] = -__expf(-sp - 0.5f);
          aa[e] = __builtin_amdgcn_rcpf(1.f + __expf(-(a0v[e] + al[e])));
          kk[e] = k8[e] * kkv[e]; ssq += kk[e] * kk[e];
      }
      ssq += __shfl_xor(ssq, 1); ssq += __shfl_xor(ssq, 2); ssq += __shfl_xor(ssq, 4);
      const float kinv = __builtin_amdgcn_rsqf(fmaxf(ssq, 1e-24f));
      float bon = 0.f;
#pragma unroll
      for (int e = 0; e < 8; ++e) { kk[e] *= kinv; k8[e] = k8[e] * (1.f + (aa[e] - 1.f) * kav[e]); bon += r8[e] * k8[e] * rkv[e]; av8[e] = -kk[e]; bv8[e] = kk[e] * aa[e]; }
      bon += __shfl_xor(bon, 1); bon += __shfl_xor(bon, 2); bon += __shfl_xor(bon, 4);
      float bv[8];
#pragma unroll
      for (int e = 0; e < 8; ++e) bv[e] = bon * v8[e];
      const size_t go = (size_t)item * 4096 + t * 64 + jg * 8;
      *(u32x4*)((bf16_t*)(p.ws + WS_GATE) + go) = pack8(gg);
      *(u32x4*)((bf16_t*)(p.ws + WS_BONUS) + go) = pack8(bv);
      *(LAS f32x4*)(lds + R_DL + t * FS + jg * 32) = (f32x4){ld[0], ld[1], ld[2], ld[3]};
      *(LAS f32x4*)(lds + R_DL + t * FS + jg * 32 + 16) = (f32x4){ld[4], ld[5], ld[6], ld[7]};
    }
    __syncthreads();
    { const int j = tid & 63, seg = tid >> 6; float run = 0.f;
#pragma unroll
      for (int i = 0; i < 8; ++i) { LAS float* q = (LAS float*)(lds + R_DL + (seg * 8 + i) * FS + j * 4); run += *q; *q = run; }
      *(LAS float*)(lds + R_SEG + (seg * 64 + j) * 4) = run;
      __syncthreads();
      float pre = 0.f;
      for (int s2 = 0; s2 < seg; ++s2) pre += *(const LAS float*)(lds + R_SEG + (s2 * 64 + j) * 4);
#pragma unroll
      for (int i = 0; i < 8; ++i) { LAS float* q = (LAS float*)(lds + R_DL + (seg * 8 + i) * FS + j * 4); *q += pre; } }
    __syncthreads();
    { float L[8], Lp[8], LC[8];
      { const f32x4 x0 = *(const LAS f32x4*)(lds + R_DL + t * FS + jg * 32), x1 = *(const LAS f32x4*)(lds + R_DL + t * FS + jg * 32 + 16);
        const f32x4 c0 = *(const LAS f32x4*)(lds + R_DL + 63 * FS + jg * 32), c1 = *(const LAS f32x4*)(lds + R_DL + 63 * FS + jg * 32 + 16);
        f32x4 p0 = {0.f, 0.f, 0.f, 0.f}, p1 = p0;
        if (t > 0) { p0 = *(const LAS f32x4*)(lds + R_DL + (t - 1) * FS + jg * 32); p1 = *(const LAS f32x4*)(lds + R_DL + (t - 1) * FS + jg * 32 + 16); }
#pragma unroll
        for (int e = 0; e < 4; ++e) { L[e] = x0[e]; L[4 + e] = x1[e]; LC[e] = c0[e]; LC[4 + e] = c1[e]; Lp[e] = p0[e]; Lp[4 + e] = p1[e]; } }
      float at[8], bt[8], kt[8], rt[8];
#pragma unroll
      for (int e = 0; e < 8; ++e) {
          const float eL = __expf(L[e]), eLp = __expf(Lp[e]), einv = __expf(-L[e]), eC = __expf(LC[e] - L[e]);
          at[e] = av8[e] * eLp; bt[e] = bv8[e] * einv; kt[e] = k8[e] * einv; rt[e] = r8[e] * eL;
          const int ch = jg * 8 + e;
          *(LAS unsigned short*)(lds + R_VT + ch * TS + t * 2) = f2bf(v8[e]);
          *(LAS unsigned short*)(lds + R_BH + ch * TS + t * 2) = f2bf(bv8[e] * eC);
          *(LAS unsigned short*)(lds + R_KH + ch * TS + t * 2) = f2bf(k8[e] * eC);
          if (t == 63) ((float*)(p.ws + WS_GAM))[(size_t)item * 64 + ch] = __expf(LC[e]);
      }
      *(LAS f32x4*)(lds + R_RHS + t * RS + jg * 32) = (f32x4){at[0], at[1], at[2], at[3]};
      *(LAS f32x4*)(lds + R_RHS + t * RS + jg * 32 + 16) = (f32x4){at[4], at[5], at[6], at[7]};
      *(LAS u32x4*)(lds + R_AT + t * TS + jg * 16) = pack8(at);
      *(LAS u32x4*)(lds + R_BT + t * TS + jg * 16) = pack8(bt);
      *(LAS u32x4*)(lds + R_KT + t * TS + jg * 16) = pack8(kt);
      *(LAS u32x4*)(lds + R_RT + t * TS + jg * 16) = pack8(rt);
    }
    __syncthreads();
    { const int mat = wid >> 1;
      const LAS unsigned char* Aop = lds + ((mat < 2) ? R_AT : R_RT);
      const LAS unsigned char* Bop = lds + ((mat & 1) ? R_KT : R_BT);
      const int incl = (mat >= 2) ? 1 : 0;
#pragma unroll
      for (int mm = 0; mm < 2; ++mm) { const int m = (wid & 1) ? (mm ? 2 : 1) : (mm ? 3 : 0);
#pragma unroll
          for (int n = 0; n < 4; ++n) {
              f32x4 acc = {0.f, 0.f, 0.f, 0.f};
              if (n <= m) acc = mm_lds(Aop, TS, m * 16, Bop, TS, n * 16, 64, lane, acc);
              const int tr = m * 16 + (lane & 15), s0 = n * 16 + 4 * (lane >> 4);
#pragma unroll
              for (int e = 0; e < 4; ++e) if (!(s0 + e < tr + incl)) acc[e] = 0.f;
              if (mat == 0) {
#pragma unroll
                  for (int e = 0; e < 4; ++e) *(LAS float*)(lds + R_AAB + (tr * 64 + e * 16 + n * 4 + (lane >> 4)) * 4) = acc[e];
              } else {
                  const int dst = (mat == 1) ? R_AAK : ((mat == 2) ? R_ARB : R_ARK);
                  *(LAS u32x2*)(lds + dst + tr * TS + s0 * 2) = (u32x2){cvt_pk_bf16(acc[0], acc[1]), cvt_pk_bf16(acc[2], acc[3])};
              }
          } } }
    __syncthreads();
    { const int m = wid >> 1;
#pragma unroll
      for (int nn = 0; nn < 2; ++nn) { const int n = (wid & 1) * 2 + nn;
          f32x4 acc = {0.f, 0.f, 0.f, 0.f};
          acc = mm_lds(lds + R_AAK, TS, m * 16, lds + R_VT, TS, n * 16, 64, lane, acc);
          *(LAS f32x4*)(lds + R_RHS + (m * 16 + (lane & 15)) * RS + (64 + n * 16 + 4 * (lane >> 4)) * 4) = acc; } }
    __syncthreads();
    { const int cc = lane >> 2, q = lane & 3, col = wid * 16 + cc;
      float ur[16];
#pragma unroll
      for (int i = 0; i < 16; ++i) ur[i] = *(const LAS float*)(lds + R_RHS + (4 * i + q) * RS + col * 4);
      const LAS unsigned char* abase = lds + R_AAB + q * 64;
      f32x4 ab[2][4];
      ab[1][0] = *(const LAS f32x4*)(abase + 1 * 256);
#pragma unroll
      for (int tt = 1; tt < 64; ++tt) {
          const int nI = (tt + 3) >> 2;
          if (tt < 63) { const int nJ = (tt + 4) >> 2;
#pragma unroll
              for (int i4 = 0; i4 < (nJ + 3) / 4; ++i4) ab[(tt + 1) & 1][i4] = *(const LAS f32x4*)(abase + (tt + 1) * 256 + i4 * 16); }
          float pa = 0.f, pb = 0.f;
#pragma unroll
          for (int i4 = 0; i4 < (nI + 3) / 4; ++i4) {
#pragma unroll
              for (int e = 0; e < 4; ++e) if (i4 * 4 + e < nI) { if (e & 1) pb += ab[tt & 1][i4][e] * ur[i4 * 4 + e]; else pa += ab[tt & 1][i4][e] * ur[i4 * 4 + e]; } }
          float pp = quad_sum(pa + pb);
          if (q == (tt & 3)) ur[tt >> 2] += pp;
      }
      const int dbase = (col < 64) ? (R_WT + col * TS) : (R_UT + (col - 64) * TS);
#pragma unroll
      for (int i = 0; i < 16; ++i) *(LAS unsigned short*)(lds + dbase + (4 * i + q) * 2) = f2bf(ur[i]);
    }
    __syncthreads();
    { bf16_t* MPg = (bf16_t*)(p.ws + WS_MP) + (size_t)item * 4096; bf16_t* Pg = (bf16_t*)(p.ws + WS_P) + (size_t)item * 4096;
      float* Qg = p.out + (size_t)item * 4096; float* GTg = p.out + 8388608 + (size_t)item * 4096;
#pragma unroll
      for (int oo = 0; oo < 2; ++oo) { const int o = (wid >> 2) * 2 + oo, m = wid & 3;
#pragma unroll
          for (int n = 0; n < 4; ++n) {
              f32x4 acc = {0.f, 0.f, 0.f, 0.f};
              const int rr = m * 16 + (lane & 15), c0 = n * 16 + 4 * (lane >> 4);
              if (o == 0) { acc = mm_lds(lds + R_BH, TS, m * 16, lds + R_WT, TS, n * 16, 64, lane, acc);
                  *(u32x2*)(MPg + rr * 64 + c0) = (u32x2){cvt_pk_bf16(acc[0], acc[1]), cvt_pk_bf16(acc[2], acc[3])}; }
              else if (o == 1) { acc = mm_lds(lds + R_UT, TS, m * 16, lds + R_BH, TS, n * 16, 64, lane, acc);
                  acc = mm_lds(lds + R_VT, TS, m * 16, lds + R_KH, TS, n * 16, 64, lane, acc);
                  *(f32x4*)(GTg + rr * 64 + c0) = acc; }
              else if (o == 2) { acc = mm_lds(lds + R_ARB, TS, m * 16, lds + R_WT, TS, n * 16, 64, lane, acc);
                  const u32x2 rv = *(const LAS u32x2*)(lds + R_RT + rr * TS + c0 * 2);
                  acc[0] += bf2f(rv[0] & 0xffffu); acc[1] += __uint_as_float(rv[0] & 0xffff0000u); acc[2] += bf2f(rv[1] & 0xffffu); acc[3] += __uint_as_float(rv[1] & 0xffff0000u);
                  *(u32x2*)(Pg + rr * 64 + c0) = (u32x2){cvt_pk_bf16(acc[0], acc[1]), cvt_pk_bf16(acc[2], acc[3])}; }
              else { acc = mm_lds(lds + R_ARB, TS, m * 16, lds + R_UT, TS, n * 16, 64, lane, acc);
                  acc = mm_lds(lds + R_ARK, TS, m * 16, lds + R_VT, TS, n * 16, 64, lane, acc);
                  *(f32x4*)(Qg + rr * 64 + c0) = acc; }
          } } }
    __syncthreads();
}

__device__ void phase_state(LAS unsigned char* lds, const Params& p) {
    const int tid = threadIdx.x, wid = tid >> 6, lane = tid & 63;
    const int bh = blockIdx.x >> 1, half = blockIdx.x & 1, b = bh >> 3, h = bh & 7;
    const int vl = wid >> 2, vb = half * 2 + vl, rb = wid & 3;
    const bf16_t* MP = (const bf16_t*)(p.ws + WS_MP); const float* GT = p.out + 8388608; const float* GAM = (const float*)(p.ws + WS_GAM);
    bf16_t* HST = (bf16_t*)(p.ws + WS_HST);
    const int arow = rb * 16 + (lane & 15), acol = 8 * (lane >> 4);
    const int irow = vb * 16 + (lane & 15), jcol = rb * 16 + 4 * (lane >> 4);
    f32x4 acc = {0.f, 0.f, 0.f, 0.f};
    const size_t item0 = (size_t)(b * 128) * 8 + h;
    constexpr int PD = 8;
    bf16x8 ra0[PD], ra1[PD]; f32x4 rgt[PD], rgm[PD];
#pragma unroll
    for (int u = 0; u < PD; ++u) { const size_t it = item0 + (size_t)u * 8;
        ra0[u] = *(const bf16x8*)(MP + it * 4096 + arow * 64 + acol); ra1[u] = *(const bf16x8*)(MP + it * 4096 + arow * 64 + acol + 32);
        rgt[u] = *(const f32x4*)(GT + it * 4096 + irow * 64 + jcol); rgm[u] = *(const f32x4*)(GAM + it * 64 + jcol); }
    int buf = 0;
    for (int c0 = 0; c0 < 128; c0 += PD) {
#pragma unroll
        for (int u = 0; u < PD; ++u) {
            const size_t item = item0 + (size_t)(c0 + u) * 8;
            const u32x2 pk = {cvt_pk_bf16(acc[0], acc[1]), cvt_pk_bf16(acc[2], acc[3])};
            *(LAS u32x2*)(lds + buf * 4608 + (vl * 16 + (lane & 15)) * TS + jcol * 2) = pk;
            *(u32x2*)(HST + item * 4096 + irow * 64 + jcol) = pk;
            const bf16x8 ca0 = ra0[u], ca1 = ra1[u]; const f32x4 cgt = rgt[u], cgm = rgm[u];
            if (c0 + PD < 128) { const size_t ni = item + (size_t)PD * 8;
                ra0[u] = *(const bf16x8*)(MP + ni * 4096 + arow * 64 + acol); ra1[u] = *(const bf16x8*)(MP + ni * 4096 + arow * 64 + acol + 32);
                rgt[u] = *(const f32x4*)(GT + ni * 4096 + irow * 64 + jcol); rgm[u] = *(const f32x4*)(GAM + ni * 64 + jcol); }
            __syncthreads();
            const bf16x8 b0 = *(const LAS bf16x8*)(lds + buf * 4608 + (vl * 16 + (lane & 15)) * TS + (lane >> 4) * 16);
            const bf16x8 b1 = *(const LAS bf16x8*)(lds + buf * 4608 + (vl * 16 + (lane & 15)) * TS + (lane >> 4) * 16 + 64);
            acc = cgm * acc + cgt;
            acc = __builtin_amdgcn_mfma_f32_16x16x32_bf16(ca0, b0, acc, 0, 0, 0);
            acc = __builtin_amdgcn_mfma_f32_16x16x32_bf16(ca1, b1, acc, 0, 0, 0);
            buf ^= 1;
        }
    }
}

__device__ void phase_out(const Params& p) {
    const int tid = threadIdx.x, wid = tid >> 6, lane = tid & 63, sub = wid >> 2, mt = wid & 3;
    const bf16_t* Pm = (const bf16_t*)(p.ws + WS_P); const bf16_t* HST = (const bf16_t*)(p.ws + WS_HST); const float* Q = p.out;
    const bf16_t* GA = (const bf16_t*)(p.ws + WS_GATE); const bf16_t* BO = (const bf16_t*)(p.ws + WS_BONUS); bf16_t* mix = (bf16_t*)(p.ws + WS_MIX);
    for (int u = (int)blockIdx.x; u < 1024; u += (int)gridDim.x) {
        const size_t item = (size_t)u * 2 + sub; const int h = (int)(item & 7), c = (int)((item >> 3) & 127), b = (int)(item >> 10);
        const int tr = mt * 16 + (lane & 15);
        const bf16x8 a0 = *(const bf16x8*)(Pm + item * 4096 + tr * 64 + 8 * (lane >> 4)), a1 = *(const bf16x8*)(Pm + item * 4096 + tr * 64 + 8 * (lane >> 4) + 32);
        f32x4 y[4]; float s = 0.f;
#pragma unroll
        for (int n = 0; n < 4; ++n) {
            const bf16_t* hp = HST + item * 4096 + (n * 16 + (lane & 15)) * 64 + 8 * (lane >> 4);
            const bf16x8 b0 = *(const bf16x8*)hp, b1 = *(const bf16x8*)(hp + 32);
            f32x4 acc = *(const f32x4*)(Q + item * 4096 + tr * 64 + n * 16 + 4 * (lane >> 4));
            acc = __builtin_amdgcn_mfma_f32_16x16x32_bf16(b0, a0, acc, 0, 0, 0);
            acc = __builtin_amdgcn_mfma_f32_16x16x32_bf16(b1, a1, acc, 0, 0, 0);
            y[n] = acc; s += acc[0] + acc[1] + acc[2] + acc[3];
        }
        s += __shfl_xor(s, 16); s += __shfl_xor(s, 32);
        const float mu = s * (1.f / 64.f); float vs = 0.f;
#pragma unroll
        for (int n = 0; n < 4; ++n)
#pragma unroll
            for (int e = 0; e < 4; ++e) { const float d = y[n][e] - mu; vs += d * d; }
        vs += __shfl_xor(vs, 16); vs += __shfl_xor(vs, 32);
        const float rstd = rsqrtf(vs * (1.f / 64.f) + 64e-5f);
        const size_t orow = (size_t)(b * SEQ + c * 64 + tr) * DM + 512 + h * 64;
#pragma unroll
        for (int n = 0; n < 4; ++n) { const int i0 = n * 16 + 4 * (lane >> 4);
            const float4 lw = *(const float4*)(p.lnx_w + h * 64 + i0), lb = *(const float4*)(p.lnx_b + h * 64 + i0);
            const u32x2 gv = *(const u32x2*)(GA + item * 4096 + tr * 64 + i0), bv = *(const u32x2*)(BO + item * 4096 + tr * 64 + i0);
            const float g0 = bf2f(gv[0] & 0xffffu), g1 = __uint_as_float(gv[0] & 0xffff0000u), g2 = bf2f(gv[1] & 0xffffu), g3 = __uint_as_float(gv[1] & 0xffff0000u);
            const float o0 = bf2f(bv[0] & 0xffffu), o1 = __uint_as_float(bv[0] & 0xffff0000u), o2 = bf2f(bv[1] & 0xffffu), o3 = __uint_as_float(bv[1] & 0xffff0000u);
            const float r0 = ((y[n][0] - mu) * rstd * lw.x + lb.x + o0) * g0, r1 = ((y[n][1] - mu) * rstd * lw.y + lb.y + o1) * g1,
                        r2 = ((y[n][2] - mu) * rstd * lw.z + lb.z + o2) * g2, r3 = ((y[n][3] - mu) * rstd * lw.w + lb.w + o3) * g3;
            *(u32x2*)(mix + orow + i0) = (u32x2){cvt_pk_bf16(r0, r1), cvt_pk_bf16(r2, r3)}; }
    }
}


#ifndef DIAG
#define DIAG 0
#endif
__device__ void dump_bf16(const bf16_t* src, int ld, int coff, float* out) {
    for (size_t i = (size_t)blockIdx.x * 512 + threadIdx.x; i < (size_t)MTOK * DM; i += (size_t)gridDim.x * 512) {
        const size_t r = i >> 10, c = i & 1023; float v = bf2f(src[r * ld + coff + c]); if (!(v == v) || fabsf(v) > 1e30f) v = 7777.f; out[i] = v; }
}
__global__ void __launch_bounds__(512, 2) fwd_megakernel(Params p) {
    extern __shared__ __attribute__((aligned(16))) unsigned char shm[];
    LAS unsigned char* lds = (LAS unsigned char*)shm;
    cg::grid_group grid = cg::this_grid();
    if (p.ws == nullptr) grid.sync();
    if (threadIdx.x < 4) *(volatile LAS unsigned*)(lds + LDS_ST + threadIdx.x * 4) = 0u;
    __syncthreads();
    const XcdBarrier xbar = xcd_barrier_post((unsigned*)(p.ws + WS_BAR), (volatile LAS unsigned*)(lds + LDS_ST));
#define GSYNC() xcd_barrier(xbar)
    float* mod = (float*)(p.ws + WS_MOD);
    phase0(lds, p);
    GSYNC();
    phase_norm(p.x, p.norm1_g, mod, 0, 1024, (bf16_t*)(p.ws + WS_H));
    GSYNC();
    { EpiZ e; e.O = (bf16_t*)(p.ws + WS_Z); e.ldc = INC; run_gemm(lds, (const bf16_t*)(p.ws + WS_H), (const bf16_t*)(p.ws + WS_WIN), INC, 1024, e); }
    if (blockIdx.x >= 64) conv_run((LAS float*)lds, p, 624 + (int)blockIdx.x - 64, (int)gridDim.x - 64, 2992);
    GSYNC();
    if (DIAG == 2) { dump_bf16((const bf16_t*)(p.ws + WS_Z), INC, 0, p.out); return; }
    if (DIAG == 3) { dump_bf16((const bf16_t*)(p.ws + WS_Z), INC, 1024, p.out); return; }
    for (int it = (int)blockIdx.x; it < 2048; it += (int)gridDim.x) scan_pre_item(lds, p, it);
    GSYNC();
    if (blockIdx.x < 32) phase_state(lds, p);
    else for (int it = (int)blockIdx.x - 32; it < 1024; it += (int)gridDim.x - 32) pool_item(lds, p, it >> 2, it & 3);
    GSYNC();
    phase_out(p);
    GSYNC();
    if (DIAG == 5) { dump_bf16((const bf16_t*)(p.ws + WS_MIX), DM, 0, p.out); return; }
    { EpiRes e; e.xin = p.x; e.out = p.out; e.gate = mod + 2048; run_gemm(lds, (const bf16_t*)(p.ws + WS_MIX), (const bf16_t*)(p.ws + WS_WOUT), 1024, 1024, e); }
    GSYNC();
    phase_norm(p.out, p.norm2_g, mod, 3072, 4096, (bf16_t*)(p.ws + WS_H));
    GSYNC();
    { EpiAct e; e.O = (bf16_t*)(p.ws + WS_ACT); run_gemm(lds, (const bf16_t*)(p.ws + WS_H), (const bf16_t*)(p.ws + WS_WGU), 2 * DFF, 1024, e); }
    GSYNC();
    { EpiRes e; e.xin = p.out; e.out = p.out; e.gate = mod + 5120; run_gemm(lds, (const bf16_t*)(p.ws + WS_ACT), (const bf16_t*)(p.ws + WS_WDN), 1024, DFF, e); }
    GSYNC();
    phase_final(p.out, p.final_g);
}

extern "C" void kernel_launch(void* const* d_in, const int* in_sizes, int n_in, void* d_out, int out_size, void* d_ws, size_t ws_size, hipStream_t stream) {
    static int grid_blocks = 0;
    if (!grid_blocks) {
        int dev = 0, cus = 0, per_cu = 0;
        hipGetDevice(&dev);
        hipDeviceGetAttribute(&cus, hipDeviceAttributeMultiprocessorCount, dev);
        hipFuncSetAttribute((const void*)fwd_megakernel, hipFuncAttributeMaxDynamicSharedMemorySize, LDS_BYTES);
        hipOccupancyMaxActiveBlocksPerMultiprocessor(&per_cu, (const void*)fwd_megakernel, 512, LDS_BYTES);
        if (per_cu < 1) { fprintf(stderr, "occupancy query says %d blocks/CU\n", per_cu); per_cu = 1; }
        grid_blocks = cus * 1;
        (void)hipGetLastError();
    }
    Params p{};
    const float** f = (const float**)&p;
    for (int i = 0; i < 24; ++i) f[i] = (const float*)d_in[i];
    p.out = (float*)d_out; p.ws = (unsigned char*)d_ws;
    (void)hipMemsetAsync((unsigned char*)d_ws + WS_BAR, 0, XCD_BAR_WORDS * sizeof(unsigned), stream);
    (void)hipMemsetAsync((unsigned char*)d_ws + WS_MOD, 0, 2 * 6144 * sizeof(float), stream);
    void* args[] = {&p};
    hipError_t e = hipLaunchCooperativeKernel((const void*)fwd_megakernel, dim3(grid_blocks), dim3(512), args, LDS_BYTES, stream);
    if (e != hipSuccess) fprintf(stderr, "cooperative launch failed: %s (grid %d)\n", hipGetErrorString(e), grid_blocks);
}
```
